# Optimizing an MI355X kernel written in HIP

```python
import jax, jax.numpy as jnp
from jax import lax
import numpy as np

D_MODEL = 1024
BATCH = 16
SEQ = 2048
DEPTH = 1

CTX_LEN = 256
GRID_W = 64
RET_HEADS = 4
RET_DIM = 128
RET_WIDTH = RET_HEADS * RET_DIM
RET_CHUNK = 128
NA_HEADS = 8
NA_DIM = 64
NA_WIDTH = NA_HEADS * NA_DIM
NA_KH = 8
NA_KW = 16
MIX_WIDTH = RET_WIDTH + NA_WIDTH
IN_SPLITS = (RET_WIDTH, RET_WIDTH, RET_WIDTH, RET_WIDTH, NA_WIDTH, NA_WIDTH, NA_WIDTH)
IN_WIDTH = 4 * RET_WIDTH + 3 * NA_WIDTH
D_FF = 4 * D_MODEL
ROPE_BASE = 10000.0
NORM_EPS = 1e-6
N_MOD = 6
NEG_INF = -1e30

kernel_name = 'hybrid_retention_natten_dit_block'


def rmsnorm(x, g):
    xf = x.astype(jnp.float32)
    y = xf * lax.rsqrt(jnp.mean(xf * xf, axis=-1, keepdims=True) + NORM_EPS)
    return (y * g.astype(jnp.float32)).astype(x.dtype)


def modulations(cvec, w_ada, b_ada):
    return jnp.split(jax.nn.silu(cvec) @ w_ada + b_ada, N_MOD, axis=-1)


def to_heads(t, n_heads):
    b, l, _ = t.shape
    return t.reshape(b, l, n_heads, -1).transpose(0, 2, 1, 3)


def axial_rope(x, pos_r, pos_c):
    d_axis = x.shape[-1] // 2
    n_freq = d_axis // 2
    inv = ROPE_BASE ** (-jnp.arange(n_freq, dtype=jnp.float32) / n_freq)

    def rot(seg, pos):
        ang = pos[:, None] * inv[None, :]
        cos, sin = jnp.cos(ang), jnp.sin(ang)
        s1 = seg[..., :n_freq].astype(jnp.float32)
        s2 = seg[..., n_freq:].astype(jnp.float32)
        return jnp.concatenate([s1 * cos - s2 * sin, s1 * sin + s2 * cos], axis=-1)

    out = jnp.concatenate([rot(x[..., :d_axis], pos_r), rot(x[..., d_axis:], pos_c)], axis=-1)
    return out.astype(x.dtype)


def retention_scan(q, k, v, log_gamma, state0, strict):
    b, h, l, dk = q.shape
    dv = v.shape[-1]
    nc = l // RET_CHUNK
    qc = (q * dk ** -0.5).reshape(b, h, nc, RET_CHUNK, dk)
    kc = k.reshape(b, h, nc, RET_CHUNK, dk)
    vc = v.reshape(b, h, nc, RET_CHUNK, dv)
    lg = log_gamma.astype(jnp.float32)[:, None]
    i = jnp.arange(RET_CHUNK, dtype=jnp.float32)
    diff = i[:, None] - i[None, :]
    mask = (diff > 0) if strict else (diff >= 0)
    decay = jnp.where(mask, jnp.exp(lg[:, :, None] * jnp.where(mask, diff, 0.0)), 0.0)
    scores = jnp.einsum('bhnid,bhnjd->bhnij', qc, kc) * decay[:, None]
    inner = jnp.einsum('bhnij,bhnje->bhnie', scores, vc)
    k_w = kc * jnp.exp(lg * (RET_CHUNK - 1.0 - i))[:, None, :, None]
    upd = jnp.einsum('bhnjd,bhnje->nbhde', k_w, vc).astype(jnp.float32)
    chunk_decay = jnp.exp(lg * RET_CHUNK)[:, :, None]

    def step(state, u):
        return chunk_decay * state + u, state

    state_final, state_prev = lax.scan(step, state0.astype(jnp.float32), upd)
    q_w = qc * jnp.exp(lg * (i + 1.0))[:, None, :, None]
    cross = jnp.einsum('bhnid,nbhde->bhnie', q_w, state_prev)
    out = (inner + cross).reshape(b, h, l, dv).astype(v.dtype)
    return out, state_final


def head_layernorm(o, w):
    of = o.astype(jnp.float32)
    mu = jnp.mean(of, axis=-1, keepdims=True)
    var = jnp.mean(jnp.square(of - mu), axis=-1, keepdims=True)
    y = (of - mu) * lax.rsqrt(var + NORM_EPS)
    b, h, l, dv = o.shape
    y = y.transpose(0, 2, 1, 3).reshape(b, l, h * dv)
    return (y * w.astype(jnp.float32)).astype(o.dtype)


def retention_mixer(q, k, v, g, qc, kc, vc, gc, log_gammas, gn_w, with_ctx_out):
    n = q.shape[1]
    tok = jnp.arange(n)
    pos_r = (tok // GRID_W).astype(jnp.float32)
    pos_c = (tok % GRID_W).astype(jnp.float32)
    q = axial_rope(to_heads(q, RET_HEADS), pos_r, pos_c)
    k = axial_rope(to_heads(k, RET_HEADS), pos_r, pos_c)
    v = to_heads(v, RET_HEADS)
    qc, kc, vc = to_heads(qc, RET_HEADS), to_heads(kc, RET_HEADS), to_heads(vc, RET_HEADS)
    b = q.shape[0]
    zero = jnp.zeros((b, RET_HEADS, RET_DIM, RET_DIM), jnp.float32)

    def flip(t):
        return jnp.flip(t, axis=2)

    ctx_f, s_f = retention_scan(qc, kc, vc, log_gammas[0], zero, False)
    lat_f, _ = retention_scan(q, k, v, log_gammas[0], s_f, False)
    ctx_b, s_b = retention_scan(flip(qc), flip(kc), flip(vc), log_gammas[1], zero, True)
    lat_b, _ = retention_scan(flip(q), flip(k), flip(v), log_gammas[1], s_b, True)
    lat = head_layernorm(lat_f + flip(lat_b), gn_w) * jax.nn.silu(g)
    ctx_out = None
    if with_ctx_out:
        ctx_out = head_layernorm(ctx_f + flip(ctx_b), gn_w) * jax.nn.silu(gc)
    return lat, ctx_out


def neighbourhood_attention(q, k, v, kc, vc, rpb):
    b, n, _ = q.shape
    rows = n // GRID_W
    kh = min(NA_KH, rows)

    def grid(t):
        return t.reshape(b, rows, GRID_W, NA_HEADS, NA_DIM).transpose(0, 3, 1, 2, 4)

    qg = grid(q) * NA_DIM ** -0.5
    kg, vg = grid(k), grid(v)
    kc, vc = to_heads(kc, NA_HEADS), to_heads(vc, NA_HEADS)
    r = jnp.arange(rows)
    row_idx = jnp.clip(r - kh // 2, 0, rows - kh)[:, None] + jnp.arange(kh)[None, :]
    nk = kh * GRID_W
    k_band = kg[:, :, row_idx].reshape(b, NA_HEADS, rows, nk, NA_DIM)
    v_band = vg[:, :, row_idx].reshape(b, NA_HEADS, rows, nk, NA_DIM)
    col = jnp.arange(GRID_W)
    col_start = jnp.clip(col - NA_KW // 2, 0, GRID_W - NA_KW)
    key_col = jnp.tile(col, kh)
    key_row = jnp.repeat(row_idx, GRID_W, axis=1)
    valid = (key_col[None, :] >= col_start[:, None]) & (key_col[None, :] < col_start[:, None] + NA_KW)
    dr = key_row - r[:, None] + (NA_KH - 1)
    dc = jnp.clip(key_col[None, :] - col[:, None] + (NA_KW - 1), 0, 2 * NA_KW - 2)
    bias = rpb[:, dr[:, None, :], dc[None, :, :]].astype(jnp.float32)
    bias = jnp.where(valid[None, None], bias, NEG_INF)
    s_loc = jnp.einsum('bhrqd,bhrkd->bhrqk', qg, k_band).astype(jnp.float32) + bias
    s_ctx = jnp.einsum('bhrqd,bhkd->bhrqk', qg, kc).astype(jnp.float32)
    p = jax.nn.softmax(jnp.concatenate([s_loc, s_ctx], axis=-1), axis=-1).astype(v.dtype)
    out = (jnp.einsum('bhrqk,bhrkd->bhrqd', p[..., :nk], v_band)
           + jnp.einsum('bhrqk,bhkd->bhrqd', p[..., nk:], vc))
    return out.transpose(0, 2, 3, 1, 4).reshape(b, n, NA_WIDTH)


def context_attention(qc, kc, vc):
    b, l, _ = qc.shape
    q, k, v = to_heads(qc, NA_HEADS), to_heads(kc, NA_HEADS), to_heads(vc, NA_HEADS)
    s = jnp.einsum('bhqd,bhkd->bhqk', q * NA_DIM ** -0.5, k).astype(jnp.float32)
    p = jax.nn.softmax(s, axis=-1).astype(v.dtype)
    o = jnp.einsum('bhqk,bhkd->bhqd', p, v)
    return o.transpose(0, 2, 1, 3).reshape(b, l, NA_WIDTH)


def squared_relu_mlp(h, w1, w2):
    return jnp.square(jax.nn.relu(h @ w1)) @ w2


def hybrid_layer(x, ctx, c, c_ctx, w_ada, b_ada, g_pre_mix, g_post_mix, g_pre_mlp, g_post_mlp,
                 w_in, ret_decay, ret_gn, na_rpb, w_out, w_mlp1, w_mlp2, update_ctx):
    sh1, sc1, gt1, sh2, sc2, gt2 = modulations(c[:, None, :], w_ada, b_ada)
    csh1, csc1, cgt1, csh2, csc2, cgt2 = modulations(c_ctx, w_ada, b_ada)
    split_at = [int(s) for s in np.cumsum(IN_SPLITS)[:-1]]
    h = rmsnorm(x, g_pre_mix) * (1.0 + sc1) + sh1
    hc = rmsnorm(ctx, g_pre_mix) * (1.0 + csc1) + csh1
    rq, rk, rv, rg, nq, nk, nv = jnp.split(h @ w_in, split_at, axis=-1)
    crq, crk, crv, crg, cnq, cnk, cnv = jnp.split(hc @ w_in, split_at, axis=-1)
    log_gammas = jax.nn.log_sigmoid(ret_decay.astype(jnp.float32))
    ret_lat, ret_ctx = retention_mixer(rq, rk, rv, rg, crq, crk, crv, crg, log_gammas, ret_gn, update_ctx)
    na_lat = neighbourhood_attention(nq, nk, nv, cnk, cnv, na_rpb)
    mix = jnp.concatenate([ret_lat, na_lat], axis=-1) @ w_out
    x = x + gt1 * rmsnorm(mix, g_post_mix)
    h2 = rmsnorm(x, g_pre_mlp) * (1.0 + sc2) + sh2
    x = x + gt2 * rmsnorm(squared_relu_mlp(h2, w_mlp1, w_mlp2), g_post_mlp)
    if update_ctx:
        na_ctx = context_attention(cnq, cnk, cnv)
        mix_c = jnp.concatenate([ret_ctx, na_ctx], axis=-1) @ w_out
        ctx = ctx + cgt1 * rmsnorm(mix_c, g_post_mix)
        hc2 = rmsnorm(ctx, g_pre_mlp) * (1.0 + csc2) + csh2
        ctx = ctx + cgt2 * rmsnorm(squared_relu_mlp(hc2, w_mlp1, w_mlp2), g_post_mlp)
    return x, ctx


def setup_inputs(seed: int = 0) -> dict:
    key = jax.random.key(seed)
    ks = jax.random.split(key, 17)

    def nrm(k, shape, s):
        return jax.random.normal(k, shape, jnp.float32) * s

    base_logit = jnp.log(2.0 ** (5.0 + jnp.arange(RET_HEADS, dtype=jnp.float32)) - 1.0)
    return {
        'x': nrm(ks[0], (BATCH, SEQ, D_MODEL), 1.0),
        'c': nrm(ks[1], (BATCH, D_MODEL), 1.0),
        'ctx': nrm(ks[2], (BATCH, CTX_LEN, D_MODEL), 1.0),
        'c_ctx': nrm(ks[3], (D_MODEL,), 1.0),
        'w_ada': nrm(ks[4], (DEPTH, D_MODEL, N_MOD * D_MODEL), D_MODEL ** -0.5),
        'b_ada': nrm(ks[5], (DEPTH, N_MOD * D_MODEL), 0.02),
        'g_pre_mix': 1.0 + nrm(ks[6], (DEPTH, D_MODEL), 0.02),
        'g_post_mix': 1.0 + nrm(ks[7], (DEPTH, D_MODEL), 0.02),
        'g_pre_mlp': 1.0 + nrm(ks[8], (DEPTH, D_MODEL), 0.02),
        'g_post_mlp': 1.0 + nrm(ks[9], (DEPTH, D_MODEL), 0.02),
        'w_in': nrm(ks[10], (DEPTH, D_MODEL, IN_WIDTH), D_MODEL ** -0.5),
        'ret_decay': base_logit[None, None, :] + nrm(ks[11], (DEPTH, 2, RET_HEADS), 0.1),
        'ret_gn': 1.0 + nrm(ks[12], (DEPTH, RET_WIDTH), 0.02),
        'na_rpb': nrm(ks[13], (DEPTH, NA_HEADS, 2 * NA_KH - 1, 2 * NA_KW - 1), 0.1),
        'w_out': nrm(ks[14], (DEPTH, MIX_WIDTH, D_MODEL), MIX_WIDTH ** -0.5),
        'w_mlp1': nrm(ks[15], (DEPTH, D_MODEL, D_FF), D_MODEL ** -0.5),
        'w_mlp2': nrm(ks[16], (DEPTH, D_FF, D_MODEL), D_FF ** -0.5),
    }


def reference(x, c, ctx, c_ctx, w_ada, b_ada, g_pre_mix, g_post_mix, g_pre_mlp, g_post_mlp,
              w_in, ret_decay, ret_gn, na_rpb, w_out, w_mlp1, w_mlp2):
    for layer in range(DEPTH):
        x, ctx = hybrid_layer(x, ctx, c, c_ctx, w_ada[layer], b_ada[layer], g_pre_mix[layer],
                              g_post_mix[layer], g_pre_mlp[layer], g_post_mlp[layer], w_in[layer],
                              ret_decay[layer], ret_gn[layer], na_rpb[layer], w_out[layer],
                              w_mlp1[layer], w_mlp2[layer], update_ctx=(layer + 1 < DEPTH))
    return x
```

```cpp
#include <hip/hip_runtime.h>
#include <cstdint>
#include <cstdio>
#include <hip/hip_cooperative_groups.h>
namespace cg = cooperative_groups;

typedef unsigned short bf16_t;
typedef unsigned u32x4 __attribute__((ext_vector_type(4)));
typedef float f32x4 __attribute__((ext_vector_type(4)));

constexpr int D = 1024, NB = 16, SEQ = 2048, CTX = 256, ML = NB * SEQ, MC = NB * CTX, MT = ML + MC;
constexpr int INW = 3584, FF = 4096;
constexpr int C_RQ = 0, C_RK = 512, C_RV = 1024, C_RG = 1536, C_NQ = 2048, C_NK = 2560, C_NV = 3072;
constexpr float EPS = 1e-6f;
constexpr size_t MiB = 1u << 20;
constexpr size_t WS_MOD = 1 * MiB, WS_XN = 32 * MiB, WS_QKV = 104 * MiB, WS_HID = 104 * MiB, WS_MIX = 360 * MiB, WS_Y = 360 * MiB, WS_END = 488 * MiB;

__device__ __forceinline__ float bf2f(bf16_t v) { return __uint_as_float(((unsigned)v) << 16); }
__device__ __forceinline__ bf16_t f2bf(float f) { unsigned u = __float_as_uint(f); return (bf16_t)((u + 0x7fffu + ((u >> 16) & 1u)) >> 16); }
__device__ __forceinline__ float wave_sum(float v) {
#pragma unroll
    for (int o = 1; o < 64; o <<= 1) v += __shfl_xor(v, o);
    return v;
}
__device__ __forceinline__ float wave_max(float v) {
#pragma unroll
    for (int o = 1; o < 64; o <<= 1) v = fmaxf(v, __shfl_xor(v, o));
    return v;
}
typedef float f32x2_t __attribute__((ext_vector_type(2)));
typedef __bf16 bf16x2_t __attribute__((ext_vector_type(2)));
__device__ __forceinline__ unsigned pk2(float lo, float hi) { f32x2_t v = {lo, hi}; bf16x2_t b = __builtin_convertvector(v, bf16x2_t); return __builtin_bit_cast(unsigned, b); }
__device__ __forceinline__ float siluf(float v) { return v / (1.f + __expf(-v)); }

namespace pg8 {
#define PG8_LAS __attribute__((address_space(3)))
typedef short bf16x8 __attribute__((ext_vector_type(8)));
constexpr int BM = 256, BK = 64, HALF = 128, HTB = HALF * BK * 2, STAGE_BYTES = 8 * HTB, NXCD = 8, WGM = 8;
__host__ __device__ __forceinline__ int lds_byte(int r, int c) { const int st = (r >> 4) * 2 + (c >> 5), rr = r & 15, cc = c & 31, ob = rr * 64 + cc * 2; return st * 1024 + (ob ^ (((ob >> 9) & 1) << 5)); }
__host__ __device__ __forceinline__ void stage_rc(int b, int& R, int& C) { const int st = b / 1024, sb = b % 1024, swz = sb ^ (((sb >> 9) & 1) << 5); R = (st >> 1) * 16 + swz / 64; C = (st & 1) * 32 + (swz % 64) / 2; }
__host__ __device__ __forceinline__ int perm32(int rho) { const int n = rho >> 4, i = rho & 15; return 8 * (i >> 2) + 4 * n + (i & 3); }
struct Unit { int pm, pn; };
struct Gemm { const bf16_t* A; const bf16_t* Bt; int M, N, K; };
struct StaticOrder {
    int nM, nN, nwg, G, c;
    __host__ __device__ void init(int M, int N, int G_, int c_) { nM = M / BM; nN = N / BM; nwg = nM * nN; G = G_; c = c_; }
    __host__ __device__ bool next(int i, Unit& u) const {
        const long L = (long)i * G + c; if (L >= nwg) return false;
        int wgid = (int)L; { const int q = nwg / NXCD, r = nwg % NXCD, xcd = wgid % NXCD, off = wgid / NXCD; wgid = (xcd < r ? xcd * (q + 1) : r * (q + 1) + (xcd - r) * q) + off; }
        const int nig = WGM * nN, gid = wgid / nig, fm = gid * WGM, gsz = (nM - fm) < WGM ? (nM - fm) : WGM;
        u.pm = fm + ((wgid % nig) % gsz); u.pn = (wgid % nig) / gsz; return true;
    }
};
__device__ __forceinline__ unsigned cvt_pk_bf16(float lo, float hi) { unsigned r; asm volatile("v_cvt_pk_bf16_f32 %0, %1, %2" : "=v"(r) : "v"(lo), "v"(hi)); return r; }

template <int ACT  > struct EpiBf16 {
    static constexpr bool PERM = true;
    bf16_t* O; int ldc;
    __device__ __forceinline__ void operator()(const f32x4 (&acc)[2][2][4][2], const Unit& u, int wr, int wc, int fr, int fq) const {
        const int row0 = u.pm * BM + wr * 64 + fr; const int col0 = u.pn * BM + wc * 32 + 8 * fq;
#pragma unroll
        for (int ai = 0; ai < 2; ++ai)
#pragma unroll
            for (int m = 0; m < 4; ++m) { bf16_t* rowp = O + (size_t)(row0 + ai * HALF + m * 16) * ldc + col0;
#pragma unroll
                for (int bj = 0; bj < 2; ++bj) { f32x4 v0 = acc[ai][bj][m][0], v1 = acc[ai][bj][m][1];
                    if (ACT == 1) {
#pragma unroll
                        for (int e = 0; e < 4; ++e) { float a = fmaxf(v0[e], 0.f); v0[e] = a * a; float b = fmaxf(v1[e], 0.f); v1[e] = b * b; } }
                    u32x4 w; w.x = cvt_pk_bf16(v0[0], v0[1]); w.y = cvt_pk_bf16(v0[2], v0[3]); w.z = cvt_pk_bf16(v1[0], v1[1]); w.w = cvt_pk_bf16(v1[2], v1[3]);
                    __builtin_nontemporal_store(w, (u32x4*)(rowp + bj * HALF)); } }
    }
};
template <class Epi, class Sched>
__device__ __forceinline__ void gemm_phase(PG8_LAS unsigned char* lds, const Gemm g, const Sched& S, const Epi& E) {
    const int tid = threadIdx.x, wid = __builtin_amdgcn_readfirstlane(tid >> 6), lane = tid & 63, wr = wid >> 2, wc = wid & 3, fr = lane & 15, fq = lane >> 4;
    const int K = g.K, nt = K / BK;
    unsigned voffA[2], voffB[2];
#pragma unroll
    for (int i = 0; i < 2; ++i) { int R, C; stage_rc(tid * 16 + i * 8192, R, C); const int Rb = Epi::PERM ? ((R & ~31) + perm32(R & 31)) : R;
        voffA[i] = (unsigned)(R * K + C) * 2u; voffB[i] = (unsigned)(Rb * K + C) * 2u; }
    const size_t kstep = (size_t)(BK * 2);
    const size_t hstep = (size_t)HALF * K * 2;
    const size_t tstep = 2 * hstep;
    const unsigned ldsw = (unsigned)wid * 1024u;
    const int aoff = lds_byte(wr * 64 + fr, fq * 8), boff = lds_byte(wc * 32 + fr, fq * 8);
#define PG8_SA(b, h) (((b) * 2 + (h)) * HTB)
#define PG8_SB(b, h) ((4 + (b) * 2 + (h)) * HTB)
#define PG8_STAGE(bufoff, gbase, voff) do { _Pragma("unroll") for (int _i = 0; _i < 2; ++_i) \
        __builtin_amdgcn_global_load_lds((const unsigned*)((const char*)(gbase) + (voff)[_i]), (PG8_LAS unsigned*)(lds + (bufoff) + ldsw + _i * 8192), 16, 0, 0); } while (0)
#define PG8_LDA(dst, b, h) do { _Pragma("unroll") for (int m = 0; m < 4; ++m) _Pragma("unroll") for (int k = 0; k < 2; ++k) dst[m][k] = *(const PG8_LAS bf16x8*)(lds + PG8_SA(b, h) + aoff + m * 2048 + k * 1024); } while (0)
#define PG8_LDB(dst, b, h) do { _Pragma("unroll") for (int n = 0; n < 2; ++n) _Pragma("unroll") for (int k = 0; k < 2; ++k) dst[n][k] = *(const PG8_LAS bf16x8*)(lds + PG8_SB(b, h) + boff + n * 2048 + k * 1024); } while (0)
#define PG8_MMA(ai, bj, At, Bt) do { __builtin_amdgcn_s_setprio(1); _Pragma("unroll") for (int m = 0; m < 4; ++m) _Pragma("unroll") for (int n = 0; n < 2; ++n) _Pragma("unroll") for (int k = 0; k < 2; ++k) \
        acc[ai][bj][m][n] = __builtin_amdgcn_mfma_f32_16x16x32_bf16(Bt[n][k], At[m][k], acc[ai][bj][m][n], 0, 0, 0); __builtin_amdgcn_s_setprio(0); } while (0)
#define PG8_WAIT_V(n) asm volatile("s_waitcnt vmcnt(" #n ")" ::: "memory")
#define PG8_WAIT_L(n) asm volatile("s_waitcnt lgkmcnt(" #n ")" ::: "memory")
#define PG8_BAR __builtin_amdgcn_s_barrier()
#define PG8_SCHED __builtin_amdgcn_sched_barrier(0)
    Unit cur, nxt; int ui = 0;
    if (!S.next(0, cur)) return;
    f32x4 acc[2][2][4][2];
#pragma unroll
    for (int a = 0; a < 2; ++a)
#pragma unroll
        for (int b = 0; b < 2; ++b)
#pragma unroll
            for (int m = 0; m < 4; ++m)
#pragma unroll
                for (int n = 0; n < 2; ++n) acc[a][b][m][n] = (f32x4){0.f, 0.f, 0.f, 0.f};
    bf16x8 At[4][2], B0[2][2], B1[2][2];
    const char* cA = (const char*)g.A + (size_t)cur.pm * tstep; const char* cB = (const char*)g.Bt + (size_t)cur.pn * tstep;
    PG8_STAGE(PG8_SB(0, 0), cB, voffB); PG8_STAGE(PG8_SB(0, 1), cB + hstep, voffB); PG8_STAGE(PG8_SA(0, 0), cA, voffA); PG8_STAGE(PG8_SA(0, 1), cA + hstep, voffA);
    if (wr == 1) PG8_BAR;
    PG8_WAIT_V(2); PG8_BAR;
    PG8_STAGE(PG8_SB(1, 0), cB + kstep, voffB); PG8_STAGE(PG8_SA(1, 0), cA + kstep, voffA); PG8_STAGE(PG8_SB(1, 1), cB + hstep + kstep, voffB);
    PG8_WAIT_V(6); PG8_BAR;
    for (;;) {
        const bool has_next = S.next(ui + 1, nxt);
        const char* nA = has_next ? (const char*)g.A + (size_t)nxt.pm * tstep : cA; const char* nB = has_next ? (const char*)g.Bt + (size_t)nxt.pn * tstep : cB;
        for (int t = 0; t < nt; t += 2) {
            const bool last = (t == nt - 2);
            const char* a1 = cA + (size_t)(t + 1) * kstep;
            const char* a2 = last ? nA : cA + (size_t)(t + 2) * kstep; const char* b2 = last ? nB : cB + (size_t)(t + 2) * kstep;
            const char* a3 = a2 + kstep; const char* b3 = b2 + kstep;
            PG8_LDB(B0, 0, 0); PG8_LDB(B1, 0, 1); PG8_SCHED; PG8_LDA(At, 0, 0); PG8_STAGE(PG8_SA(1, 1), a1 + hstep, voffA);
            PG8_WAIT_V(8); PG8_WAIT_L(0); PG8_BAR; PG8_MMA(0, 0, At, B0); PG8_MMA(0, 1, At, B1); PG8_BAR; PG8_SCHED;
            PG8_LDA(At, 0, 1); PG8_STAGE(PG8_SB(0, 0), b2, voffB); PG8_STAGE(PG8_SB(0, 1), b2 + hstep, voffB); PG8_STAGE(PG8_SA(0, 0), a2, voffA);
            PG8_WAIT_V(8); PG8_WAIT_L(0); PG8_BAR; PG8_MMA(1, 0, At, B0); PG8_MMA(1, 1, At, B1); PG8_BAR; PG8_SCHED;
            PG8_LDB(B0, 1, 0); PG8_LDB(B1, 1, 1); PG8_SCHED; PG8_LDA(At, 1, 0); PG8_STAGE(PG8_SA(0, 1), a2 + hstep, voffA);
            PG8_WAIT_V(8); PG8_WAIT_L(0); PG8_BAR; PG8_MMA(0, 0, At, B0); PG8_MMA(0, 1, At, B1); PG8_BAR; PG8_SCHED;
            PG8_LDA(At, 1, 1); PG8_STAGE(PG8_SB(1, 0), b3, voffB); PG8_STAGE(PG8_SB(1, 1), b3 + hstep, voffB); PG8_STAGE(PG8_SA(1, 0), a3, voffA);
            PG8_WAIT_V(8); PG8_WAIT_L(0); PG8_BAR; PG8_MMA(1, 0, At, B0); PG8_MMA(1, 1, At, B1); PG8_BAR; PG8_SCHED;
        }
        if (wr == 0) PG8_BAR;
        E(acc, cur, wr, wc, fr, fq);
        if (!has_next) break;
#pragma unroll
        for (int a = 0; a < 2; ++a)
#pragma unroll
            for (int b = 0; b < 2; ++b)
#pragma unroll
                for (int m = 0; m < 4; ++m)
#pragma unroll
                    for (int n = 0; n < 2; ++n) acc[a][b][m][n] = (f32x4){0.f, 0.f, 0.f, 0.f};
        cur = nxt; cA = nA; cB = nB; ++ui;
        if (wr == 1) PG8_BAR;
    }
    PG8_WAIT_V(0);
    PG8_BAR;
#undef PG8_SA
#undef PG8_SB
#undef PG8_STAGE
#undef PG8_LDA
#undef PG8_LDB
#undef PG8_MMA
#undef PG8_WAIT_V
#undef PG8_WAIT_L
#undef PG8_BAR
#undef PG8_SCHED
}
}


typedef short bf16x8_t __attribute__((ext_vector_type(8)));
typedef unsigned u32x2 __attribute__((ext_vector_type(2)));
#define MLAS __attribute__((address_space(3)))
#define MFMA16(a, b, c) __builtin_amdgcn_mfma_f32_16x16x32_bf16((a), (b), (c), 0, 0, 0)
constexpr size_t WS_RPF = 32 * MiB, WS_RPB = 424 * MiB, WS_ROPE = 1 * MiB + 512 * 1024;

__device__ __forceinline__ void rope_pair(u32x4& a, u32x4& b, const f32x4 c0, const f32x4 c1, const f32x4 s0, const f32x4 s1) {
    u32x4 oa, ob;
#pragma unroll
    for (int e = 0; e < 4; ++e) {
        const float x1l = __uint_as_float(a[e] << 16), x1h = __uint_as_float(a[e] & 0xffff0000u), x2l = __uint_as_float(b[e] << 16), x2h = __uint_as_float(b[e] & 0xffff0000u);
        const float cl = e < 2 ? c0[2 * e] : c1[2 * e - 4], ch = e < 2 ? c0[2 * e + 1] : c1[2 * e - 3], sl = e < 2 ? s0[2 * e] : s1[2 * e - 4], sh = e < 2 ? s0[2 * e + 1] : s1[2 * e - 3];
        oa[e] = pk2(x1l * cl - x2l * sl, x1h * ch - x2h * sh);
        ob[e] = pk2(x1l * sl + x2l * cl, x1h * sh + x2h * ch);
    }
    a = oa; b = ob;
}
__device__ __forceinline__ void ret_phase(MLAS unsigned char* lds, const bf16_t* __restrict__ QKV, const float* __restrict__ ret_decay, const float* __restrict__ ROPE, bf16_t* __restrict__ RPF, bf16_t* __restrict__ RPB, int G, int bx) {
    constexpr int RS = 272;
    constexpr int OFF_Q = 0, OFF_K = 128 * RS, OFF_KT = 2 * 128 * RS, OFF_VT = 3 * 128 * RS, OFF_ST = 3 * 128 * RS + 64 * RS;
    constexpr float QS = 0.08838834764831845f;
    const int tid = threadIdx.x, lane = tid & 63, w = __builtin_amdgcn_readfirstlane(tid >> 6), fr_ = lane & 15, fq_ = lane >> 4;
    for (int unit = bx; unit < 256; unit += G) {
        const int b = unit >> 4, h = (unit >> 2) & 3, dir = (unit >> 1) & 1, half = unit & 1, e0 = half * 64;
        const float lg2 = -log1pf(expf(-ret_decay[dir * 4 + h])) * 1.4426950408889634f;
        bf16_t* __restrict__ RP = dir ? RPB : RPF;
        const float cdec = exp2f(lg2 * 128.f);
        const int et = w & 3, dt0 = 4 * (w >> 2);
        const int i_ = 16 * w + fr_;
        float dbase[4], dstep[8];
#pragma unroll
        for (int jj = 0; jj < 4; ++jj) { const int x0 = dir ? 4 * fq_ + jj - i_ : i_ - 4 * fq_ - jj; dbase[jj] = exp2f(lg2 * (float)x0) * QS; }
#pragma unroll
        for (int nj = 0; nj < 8; ++nj) dstep[nj] = __uint_as_float(__builtin_amdgcn_readfirstlane(__float_as_uint(exp2f(lg2 * (dir ? 16.f : -16.f) * (float)nj))));
        const float csc = exp2f(lg2 * (dir ? (float)(128 - i_) : (float)(i_ + 1))) * QS;
        const int tok_ = tid & 127, dq = tid >> 7;
        const float ksc = exp2f(lg2 * (dir ? (float)tok_ : (float)(127 - tok_)));
        const float* ccp = ROPE + (tok_ & 63) * 32 + 8 * dq;
        const f32x4 cc0 = *(const f32x4*)(ccp), cc1 = *(const f32x4*)(ccp + 4), sc0 = *(const f32x4*)(ccp + 2048), sc1 = *(const f32x4*)(ccp + 2052);
        f32x4 st[4];
#pragma unroll
        for (int t = 0; t < 4; ++t) st[t] = (f32x4){0.f, 0.f, 0.f, 0.f};
        u32x4 pk4[4], pq4[4], pv2[2]; f32x4 pcr0, pcr1, psr0, psr1;
#define RET_ROWBASE(s_) ((s_) < 2 ? ML + b * CTX + 128 * (dir ? 1 - (s_) : (s_)) : b * SEQ + 128 * (dir ? 17 - (s_) : (s_) - 2))
#define RET_PREFETCH(s_) do { const int rb_ = RET_ROWBASE(s_); const bf16_t* rowp_ = QKV + (size_t)(rb_ + tok_) * INW; \
            _Pragma("unroll") for (int p = 0; p < 4; ++p) pk4[p] = *(const u32x4*)(rowp_ + C_RK + h * 128 + 8 * (dq + 4 * p)); \
            _Pragma("unroll") for (int p = 0; p < 2; ++p) pv2[p] = *(const u32x4*)(rowp_ + C_RV + h * 128 + e0 + 8 * (dq + 4 * p)); \
            if ((s_) >= 2) { _Pragma("unroll") for (int p = 0; p < 4; ++p) pq4[p] = *(const u32x4*)(rowp_ + C_RQ + h * 128 + 8 * (dq + 4 * p)); \
                const float* crp_ = ROPE + (((rb_ - b * SEQ) + tok_) >> 6) * 32 + 8 * dq; pcr0 = *(const f32x4*)(crp_); pcr1 = *(const f32x4*)(crp_ + 4); psr0 = *(const f32x4*)(crp_ + 2048); psr1 = *(const f32x4*)(crp_ + 2052); } } while (0)
        RET_PREFETCH(0);
        for (int s = 0; s < 18; ++s) {
            const bool isctx = s < 2;
            const int rowbase = RET_ROWBASE(s);
            int fr = fr_, fq = fq_, tok = tok_; asm volatile("" : "+v"(fr), "+v"(fq), "+v"(tok));
            __syncthreads();
            if (s > 0) {
#pragma unroll
                for (int t = 0; t < 4; ++t) { u32x2 pk; pk.x = pk2(st[t][0], st[t][1]); pk.y = pk2(st[t][2], st[t][3]);
                    *(MLAS u32x2*)(lds + OFF_ST + (16 * et + fr) * RS + (16 * (dt0 + t) + 4 * fq) * 2) = pk; }
            }
            if (!isctx) {
                rope_pair(pq4[0], pq4[1], pcr0, pcr1, psr0, psr1); rope_pair(pq4[2], pq4[3], cc0, cc1, sc0, sc1);
#pragma unroll
                for (int p = 0; p < 4; ++p) *(MLAS u32x4*)(lds + OFF_Q + tok * RS + (dq + 4 * p) * 16) = pq4[p];
                rope_pair(pk4[0], pk4[1], pcr0, pcr1, psr0, psr1); rope_pair(pk4[2], pk4[3], cc0, cc1, sc0, sc1);
#pragma unroll
                for (int p = 0; p < 4; ++p) *(MLAS u32x4*)(lds + OFF_K + tok * RS + (dq + 4 * p) * 16) = pk4[p];
            }
#pragma unroll
            for (int p = 0; p < 4; ++p) {
                const int dg = dq + 4 * p;
#pragma unroll
                for (int q = 0; q < 4; ++q) {
                    const unsigned wd = pk4[p][q];
                    const unsigned pr2 = pk2(__uint_as_float(wd << 16) * ksc, __uint_as_float(wd & 0xffff0000u) * ksc);
                    *(MLAS bf16_t*)(lds + OFF_KT + (8 * dg + 2 * q) * RS + tok * 2) = (bf16_t)(pr2 & 0xffffu);
                    *(MLAS bf16_t*)(lds + OFF_KT + (8 * dg + 2 * q + 1) * RS + tok * 2) = (bf16_t)(pr2 >> 16);
                }
            }
#pragma unroll
            for (int p = 0; p < 2; ++p) {
                const int dg = dq + 4 * p;
#pragma unroll
                for (int q = 0; q < 8; ++q) { const unsigned wd = pv2[p][q >> 1]; *(MLAS bf16_t*)(lds + OFF_VT + (8 * dg + q) * RS + tok * 2) = (bf16_t)((q & 1) ? (wd >> 16) : (wd & 0xffffu)); }
            }
            __builtin_amdgcn_sched_barrier(0);
            if (s + 1 < 18) RET_PREFETCH(s + 1);
            __syncthreads();
            if (!isctx) {
                const int i = 16 * w + fr;
                bf16x8_t aq[4];
#pragma unroll
                for (int ks = 0; ks < 4; ++ks) aq[ks] = *(const MLAS bf16x8_t*)(lds + OFF_Q + i * RS + (32 * ks + 8 * fq) * 2);
                f32x4 o[4];
#pragma unroll
                for (int ne = 0; ne < 4; ++ne) o[ne] = (f32x4){0.f, 0.f, 0.f, 0.f};
#pragma unroll
                for (int ne = 0; ne < 4; ++ne)
#pragma unroll
                    for (int ks = 0; ks < 4; ++ks) { const bf16x8_t bs = *(const MLAS bf16x8_t*)(lds + OFF_ST + (16 * ne + fr) * RS + (32 * ks + 8 * fq) * 2); o[ne] = MFMA16(bs, aq[ks], o[ne]); }
#pragma unroll
                for (int ne = 0; ne < 4; ++ne) o[ne] = o[ne] * csc;
                __builtin_amdgcn_sched_barrier(0);
                f32x4 sacc[8];
#pragma unroll
                for (int nj = 0; nj < 8; ++nj) { sacc[nj] = (f32x4){0.f, 0.f, 0.f, 0.f};
#pragma unroll
                    for (int ks = 0; ks < 4; ++ks) { const bf16x8_t kf = *(const MLAS bf16x8_t*)(lds + OFF_K + (16 * nj + fr) * RS + (32 * ks + 8 * fq) * 2); sacc[nj] = MFMA16(kf, aq[ks], sacc[nj]); } }
                __builtin_amdgcn_sched_barrier(0);
#pragma unroll
                for (int nj = 0; nj < 8; ++nj) {
                    float pv[4];
#pragma unroll
                    for (int jj = 0; jj < 4; ++jj) { const int j = 16 * nj + 4 * fq + jj; const bool ok = dir ? j > i : j <= i; pv[jj] = ok ? sacc[nj][jj] * dbase[jj] * dstep[nj] : 0.f; }
                    u32x2 pk; pk.x = pk2(pv[0], pv[1]); pk.y = pk2(pv[2], pv[3]);
                    *(MLAS u32x2*)(lds + OFF_Q + i * RS + (16 * nj + 4 * fq) * 2) = pk;
                }
                __builtin_amdgcn_sched_barrier(0);
#pragma unroll
                for (int ks = 0; ks < 4; ++ks) { const bf16x8_t bp = *(const MLAS bf16x8_t*)(lds + OFF_Q + i * RS + (32 * ks + 8 * fq) * 2);
#pragma unroll
                    for (int ne = 0; ne < 4; ++ne) { const bf16x8_t av = *(const MLAS bf16x8_t*)(lds + OFF_VT + (16 * ne + fr) * RS + (32 * ks + 8 * fq) * 2); o[ne] = MFMA16(av, bp, o[ne]); } }
#pragma unroll
                for (int ne = 0; ne < 4; ++ne) { u32x2 pk; pk.x = pk2(o[ne][0], o[ne][1]); pk.y = pk2(o[ne][2], o[ne][3]); *(u32x2*)(RP + (size_t)(rowbase + i) * 512 + h * 128 + e0 + 16 * ne + 4 * fq) = pk; }
            }
            __builtin_amdgcn_sched_barrier(0);
#pragma unroll
            for (int t = 0; t < 4; ++t) st[t] = st[t] * cdec;
#pragma unroll
            for (int ks = 0; ks < 4; ++ks) { const bf16x8_t bv = *(const MLAS bf16x8_t*)(lds + OFF_VT + (16 * et + fr) * RS + (32 * ks + 8 * fq) * 2);
#pragma unroll
                for (int t = 0; t < 4; ++t) { const bf16x8_t ak = *(const MLAS bf16x8_t*)(lds + OFF_KT + (16 * (dt0 + t) + fr) * RS + (32 * ks + 8 * fq) * 2); st[t] = MFMA16(ak, bv, st[t]); } }
        }
        __syncthreads();
#undef RET_ROWBASE
#undef RET_PREFETCH
    }
}
__device__ __forceinline__ void ret_combine(const bf16_t* __restrict__ RPF, const bf16_t* __restrict__ RPB, const bf16_t* __restrict__ QKV, const float* __restrict__ gn, bf16_t* __restrict__ MIX, int gw, int NGW, int lane) {
    const int col = (lane >> 4) * 128 + 8 * (lane & 15);
    f32x4 g0 = *(const f32x4*)(gn + col), g1 = *(const f32x4*)(gn + col + 4);
    for (int row = gw; row < ML; row += NGW) {
        const u32x4 av = *(const u32x4*)(RPF + (size_t)row * 512 + col), bv = *(const u32x4*)(RPB + (size_t)row * 512 + col);
        const u32x4 gv = *(const u32x4*)(QKV + (size_t)row * INW + C_RG + col);
        f32x4 v0, v1;
        v0.x = __uint_as_float(av.x << 16) + __uint_as_float(bv.x << 16); v0.y = __uint_as_float(av.x & 0xffff0000u) + __uint_as_float(bv.x & 0xffff0000u);
        v0.z = __uint_as_float(av.y << 16) + __uint_as_float(bv.y << 16); v0.w = __uint_as_float(av.y & 0xffff0000u) + __uint_as_float(bv.y & 0xffff0000u);
        v1.x = __uint_as_float(av.z << 16) + __uint_as_float(bv.z << 16); v1.y = __uint_as_float(av.z & 0xffff0000u) + __uint_as_float(bv.z & 0xffff0000u);
        v1.z = __uint_as_float(av.w << 16) + __uint_as_float(bv.w << 16); v1.w = __uint_as_float(av.w & 0xffff0000u) + __uint_as_float(bv.w & 0xffff0000u);
        float sm = (v0.x + v0.y) + (v0.z + v0.w) + (v1.x + v1.y) + (v1.z + v1.w);
#pragma unroll
        for (int o = 1; o < 16; o <<= 1) sm += __shfl_xor(sm, o);
        const float mean = sm * (1.f / 128.f);
        v0 = v0 - mean; v1 = v1 - mean;
        float sq = (v0.x * v0.x + v0.y * v0.y) + (v0.z * v0.z + v0.w * v0.w) + (v1.x * v1.x + v1.y * v1.y) + (v1.z * v1.z + v1.w * v1.w);
#pragma unroll
        for (int o = 1; o < 16; o <<= 1) sq += __shfl_xor(sq, o);
        const float rstd = rsqrtf(sq * (1.f / 128.f) + EPS);
        float y[8];
#pragma unroll
        for (int e = 0; e < 4; ++e) { y[e] = v0[e] * rstd * g0[e]; y[4 + e] = v1[e] * rstd * g1[e]; }
#pragma unroll
        for (int e = 0; e < 8; ++e) { const unsigned wd = gv[e >> 1]; const float g = (e & 1) ? __uint_as_float(wd & 0xffff0000u) : __uint_as_float(wd << 16); y[e] *= g / (1.f + __expf(-g)); }
        u32x4 ov; ov.x = pk2(y[0], y[1]); ov.y = pk2(y[2], y[3]); ov.z = pk2(y[4], y[5]); ov.w = pk2(y[6], y[7]);
        *(u32x4*)(MIX + (size_t)row * D + col) = ov;
    }
}


struct Na2Ctx { MLAS unsigned char* lds; int fr, fq, qrow, qcol, rs, cs, cb_lo; };
template <int PASS, int T0, int NT, int NDT, int VS, int OFF_K, int OFF_V, int RING>
__device__ __forceinline__ void na2_pass(const Na2Ctx& c, const int dt0, const bf16x8_t qf0, const bf16x8_t qf1, f32x4 (&o)[NDT], float& m, float& l, const unsigned (&baddr)[12]) {
    constexpr float SC = 0.125f * 1.4426950408889634f;
    const int fr = c.fr, fq = c.fq;
    __builtin_amdgcn_sched_barrier(0);
    f32x4 sa[NT];
#pragma unroll
    for (int t = 0; t < NT; ++t) {
        const int kidx = PASS == 0 ? 16 * t : ((c.rs + (T0 + t) / 3) % RING) * 64 + 16 * (c.cb_lo + (T0 + t) % 3);
        const MLAS unsigned char* kp = c.lds + OFF_K + (kidx + fr) * 144 + 16 * fq;
        const bf16x8_t k0 = *(const MLAS bf16x8_t*)(kp), k1 = *(const MLAS bf16x8_t*)(kp + 64);
        sa[t] = MFMA16(k0, qf0, ((f32x4){0.f, 0.f, 0.f, 0.f})); sa[t] = MFMA16(k1, qf1, sa[t]);
    }
    __builtin_amdgcn_sched_barrier(0);
    float mx = m;
#pragma unroll
    for (int t = 0; t < NT; ++t) {
        if (PASS == 0) { sa[t] = sa[t] * SC; }
        else {
            const int kr = (T0 + t) / 3, cbi = (T0 + t) % 3;
#pragma unroll
            for (int jj = 0; jj < 4; ++jj) { const float bias = *(const MLAS float*)(c.lds + baddr[cbi * 4 + jj] + kr * 128); sa[t][jj] = __builtin_fmaf(sa[t][jj], SC, bias); }
        }
        mx = fmaxf(mx, fmaxf(fmaxf(sa[t][0], sa[t][1]), fmaxf(sa[t][2], sa[t][3])));
    }
    __builtin_amdgcn_sched_barrier(0);
    mx = fmaxf(mx, __shfl_xor(mx, 16)); mx = fmaxf(mx, __shfl_xor(mx, 32));
    const float alpha = __builtin_amdgcn_exp2f(m - mx);
    l *= alpha;
#pragma unroll
    for (int dd = 0; dd < NDT; ++dd) o[dd] = o[dd] * alpha;
    m = mx;
#pragma unroll
    for (int t = 0; t < NT; ++t)
#pragma unroll
        for (int jj = 0; jj < 4; ++jj) { const float pv = __builtin_amdgcn_exp2f(sa[t][jj] - m); l += pv; sa[t][jj] = pv; }
    __builtin_amdgcn_sched_barrier(0);
#pragma unroll
    for (int t2 = 0; t2 < NT / 2; ++t2) {
        const int ta = 2 * t2, tb = 2 * t2 + 1;
        const int kba = PASS == 0 ? 16 * ta : ((c.rs + (T0 + ta) / 3) % RING) * 64 + 16 * (c.cb_lo + (T0 + ta) % 3);
        const int kbb = PASS == 0 ? 16 * tb : ((c.rs + (T0 + tb) / 3) % RING) * 64 + 16 * (c.cb_lo + (T0 + tb) % 3);
        u32x4 bw; bw.x = pk2(sa[ta][0], sa[ta][1]); bw.y = pk2(sa[ta][2], sa[ta][3]); bw.z = pk2(sa[tb][0], sa[tb][1]); bw.w = pk2(sa[tb][2], sa[tb][3]);
        const bf16x8_t bP = __builtin_bit_cast(bf16x8_t, bw);
#pragma unroll
        for (int dd = 0; dd < NDT; ++dd) {
            const u32x2 vlo = *(const MLAS u32x2*)(c.lds + OFF_V + (16 * (dt0 + dd) + fr) * VS + (kba + 4 * fq) * 2);
            const u32x2 vhi = *(const MLAS u32x2*)(c.lds + OFF_V + (16 * (dt0 + dd) + fr) * VS + (kbb + 4 * fq) * 2);
            u32x4 aw; aw.x = vlo.x; aw.y = vlo.y; aw.z = vhi.x; aw.w = vhi.y;
            o[dd] = MFMA16(__builtin_bit_cast(bf16x8_t, aw), bP, o[dd]);
        }
    }
    __builtin_amdgcn_sched_barrier(0);
}
__device__ __forceinline__ void na2_phase(MLAS unsigned char* lds, const bf16_t* __restrict__ QKV, const float* __restrict__ rpb, bf16_t* __restrict__ MIX, float* __restrict__ PO, float* __restrict__ PML, int G, int bx) {
    constexpr int OFF_CK = 0, OFF_CV = 256 * 144, CVS = 256 * 2 + 16;
    constexpr int OFF_K = 0, OFF_V = 576 * 144, VS = 576 * 2 + 16, OFF_RPB = OFF_V + 64 * VS;
    const int tid = threadIdx.x, lane = tid & 63, w = __builtin_amdgcn_readfirstlane(tid >> 6), fr = lane & 15, fq = lane >> 4;
    const int stok = tid & 63, sdg = tid >> 6;
    for (int rn = bx; rn < 256; rn += G) {
        const int bh = rn >> 1, R0 = 16 * (rn & 1), b = bh >> 3, h = bh & 7;
        __syncthreads();
#pragma unroll
        for (int p = 0; p < 4; ++p) {
            const int ck = tid + 512 * p, row = ck >> 3, part = ck & 7;
            const u32x4 kv = *(const u32x4*)(QKV + (size_t)(ML + b * CTX + row) * INW + C_NK + h * 64 + 8 * part);
            *(MLAS u32x4*)(lds + OFF_CK + row * 144 + part * 16) = kv;
            const int tokc = stok + 64 * p;
            const u32x4 vv = *(const u32x4*)(QKV + (size_t)(ML + b * CTX + tokc) * INW + C_NV + h * 64 + 8 * sdg);
#pragma unroll
            for (int q = 0; q < 8; ++q) { const unsigned wd = vv[q >> 1]; *(MLAS bf16_t*)(lds + OFF_CV + (8 * sdg + q) * CVS + tokc * 2) = (bf16_t)((q & 1) ? (wd >> 16) : (wd & 0xffffu)); }
        }
        __syncthreads();
#pragma nounroll
        for (int i = 0; i < 8; ++i) {
            const int qi = w + 8 * i, qrow = R0 + (qi >> 2), qcol = 16 * (qi & 3) + fr;
            const size_t tok = (size_t)(b * SEQ + qrow * 64 + qcol);
            const bf16_t* qp = QKV + tok * INW + C_NQ + h * 64 + 8 * fq;
            const bf16x8_t qf0 = *(const bf16x8_t*)(qp), qf1 = *(const bf16x8_t*)(qp + 32);
            f32x4 o[4];
#pragma unroll
            for (int dt = 0; dt < 4; ++dt) o[dt] = (f32x4){0.f, 0.f, 0.f, 0.f};
            float m = -1e30f, l = 0.f;
            const Na2Ctx cx{lds, fr, fq, qrow, qcol, 0, 0, 0};
            const unsigned bdummy[12] = {0u, 0u, 0u, 0u, 0u, 0u, 0u, 0u, 0u, 0u, 0u, 0u};
            na2_pass<0, 0, 16, 4, CVS, OFF_CK, OFF_CV, 8>(cx, 0, qf0, qf1, o, m, l, bdummy);
            l += __shfl_xor(l, 16); l += __shfl_xor(l, 32);
            float* po = PO + (tok * 8 + h) * 64 + 4 * fq;
#pragma unroll
            for (int dt = 0; dt < 4; ++dt) *(f32x4*)(po + 16 * dt) = o[dt];
            if (fq == 0) { typedef float f32x2 __attribute__((ext_vector_type(2))); *(f32x2*)(PML + (tok * 8 + h) * 2) = (f32x2){m, l}; }
        }
        typedef float f32x2 __attribute__((ext_vector_type(2)));
        const int qt = w & 3, wr2 = w >> 2;
        const int skey = tid >> 3, spart = tid & 7;
        __syncthreads();
        if (tid < 480) { const int dr_ = tid >> 5, dc_ = tid & 31; *(MLAS float*)(lds + OFF_RPB + tid * 4) = dc_ < 31 ? rpb[h * 465 + dr_ * 31 + dc_] * 1.4426950408889634f : -1e30f; }
        const int lo0 = min(max(R0 - 4, 0), 24), hi0 = min(max(R0 - 3, 0), 24) + 7;
        for (int gr = lo0; gr <= hi0; ++gr) {
            const int slot = gr % 9;
            const u32x4 kv = *(const u32x4*)(QKV + (size_t)(b * SEQ + gr * 64 + skey) * INW + C_NK + h * 64 + 8 * spart);
            *(MLAS u32x4*)(lds + OFF_K + (slot * 64 + skey) * 144 + spart * 16) = kv;
            const u32x4 vv = *(const u32x4*)(QKV + (size_t)(b * SEQ + gr * 64 + stok) * INW + C_NV + h * 64 + 8 * sdg);
#pragma unroll
            for (int q = 0; q < 8; ++q) { const unsigned wd = vv[q >> 1]; *(MLAS bf16_t*)(lds + OFF_V + (8 * sdg + q) * VS + (slot * 64 + stok) * 2) = (bf16_t)((q & 1) ? (wd >> 16) : (wd & 0xffffu)); }
        }
        int loaded_hi = hi0;
        bf16x8_t qf0, qf1; f32x2 ml; f32x4 po[4];
        { const size_t tok = (size_t)(b * SEQ + (R0 + wr2) * 64 + 16 * qt + fr); const bf16_t* qp = QKV + tok * INW + C_NQ + h * 64 + 8 * fq;
          qf0 = *(const bf16x8_t*)(qp); qf1 = *(const bf16x8_t*)(qp + 32); ml = *(const f32x2*)(PML + (tok * 8 + h) * 2);
          const float* pp = PO + (tok * 8 + h) * 64 + 4 * fq;
#pragma unroll
          for (int dt = 0; dt < 4; ++dt) po[dt] = *(const f32x4*)(pp + 16 * dt); }
        __syncthreads();
#pragma nounroll
        for (int pi = 0; pi < 8; ++pi) {
            int frl = fr, fql = fq; asm volatile("" : "+v"(frl), "+v"(fql));
            const int r0 = R0 + 2 * pi, qrow = r0 + wr2, qcol = 16 * qt + frl;
            const int rs = min(max(qrow - 4, 0), 24);
            const int cs = min(max(qcol - 8, 0), 48), cb_lo = min(max(qt - 1, 0), 1);
            const bool hasn = pi + 1 < 8;
            const int hin = min(max(r0 - 1, 0), 24) + 7;
            const int nnew = hasn ? max(hin - loaded_hi, 0) : 0;
            u32x4 nkA, nvA, nkB, nvB; bf16x8_t nq0, nq1; f32x2 nml; f32x4 no[4];
            if (nnew >= 1) { const int gr = loaded_hi + 1;
                nkA = *(const u32x4*)(QKV + (size_t)(b * SEQ + gr * 64 + skey) * INW + C_NK + h * 64 + 8 * spart);
                nvA = *(const u32x4*)(QKV + (size_t)(b * SEQ + gr * 64 + stok) * INW + C_NV + h * 64 + 8 * sdg); }
            if (nnew >= 2) { const int gr = loaded_hi + 2;
                nkB = *(const u32x4*)(QKV + (size_t)(b * SEQ + gr * 64 + skey) * INW + C_NK + h * 64 + 8 * spart);
                nvB = *(const u32x4*)(QKV + (size_t)(b * SEQ + gr * 64 + stok) * INW + C_NV + h * 64 + 8 * sdg); }
            if (hasn) { const size_t tokn = (size_t)(b * SEQ + (qrow + 2) * 64 + qcol); const bf16_t* qp = QKV + tokn * INW + C_NQ + h * 64 + 8 * fql;
                nq0 = *(const bf16x8_t*)(qp); nq1 = *(const bf16x8_t*)(qp + 32); nml = *(const f32x2*)(PML + (tokn * 8 + h) * 2);
                const float* pp = PO + (tokn * 8 + h) * 64 + 4 * fql;
#pragma unroll
                for (int dt = 0; dt < 4; ++dt) no[dt] = *(const f32x4*)(pp + 16 * dt); }
            const size_t tok = (size_t)(b * SEQ + qrow * 64 + qcol);
            float m = ml.x, l = fql == 0 ? ml.y : 0.f;
            f32x4 o[4];
#pragma unroll
            for (int dt = 0; dt < 4; ++dt) o[dt] = po[dt];
            const Na2Ctx cx{lds, frl, fql, qrow, qcol, rs, cs, cb_lo};
            unsigned baddr[12];
#pragma unroll
            for (int e = 0; e < 12; ++e) { const int kcol = 16 * (cb_lo + (e >> 2)) + 4 * fql + (e & 3); const bool ok = (unsigned)(kcol - cs) < 16u;
                baddr[e] = (unsigned)(OFF_RPB + (rs - qrow + 7) * 128 + (ok ? kcol - qcol + 15 : 31) * 4); }
            na2_pass<1, 0, 8, 4, VS, OFF_K, OFF_V, 9>(cx, 0, qf0, qf1, o, m, l, baddr);
            na2_pass<1, 8, 8, 4, VS, OFF_K, OFF_V, 9>(cx, 0, qf0, qf1, o, m, l, baddr);
            na2_pass<1, 16, 8, 4, VS, OFF_K, OFF_V, 9>(cx, 0, qf0, qf1, o, m, l, baddr);
            l += __shfl_xor(l, 16); l += __shfl_xor(l, 32);
            const float inv = 1.f / l;
            bf16_t* op = MIX + tok * D + 512 + h * 64 + 4 * fql;
#pragma unroll
            for (int dt = 0; dt < 4; ++dt) { u32x2 pk; pk.x = pk2(o[dt][0] * inv, o[dt][1] * inv); pk.y = pk2(o[dt][2] * inv, o[dt][3] * inv); *(u32x2*)(op + 16 * dt) = pk; }
            if (hasn) {
                __syncthreads();
                if (nnew >= 1) { const int slot = (loaded_hi + 1) % 9;
                    *(MLAS u32x4*)(lds + OFF_K + (slot * 64 + skey) * 144 + spart * 16) = nkA;
#pragma unroll
                    for (int q = 0; q < 8; ++q) { const unsigned wd = nvA[q >> 1]; *(MLAS bf16_t*)(lds + OFF_V + (8 * sdg + q) * VS + (slot * 64 + stok) * 2) = (bf16_t)((q & 1) ? (wd >> 16) : (wd & 0xffffu)); } }
                if (nnew >= 2) { const int slot = (loaded_hi + 2) % 9;
                    *(MLAS u32x4*)(lds + OFF_K + (slot * 64 + skey) * 144 + spart * 16) = nkB;
#pragma unroll
                    for (int q = 0; q < 8; ++q) { const unsigned wd = nvB[q >> 1]; *(MLAS bf16_t*)(lds + OFF_V + (8 * sdg + q) * VS + (slot * 64 + stok) * 2) = (bf16_t)((q & 1) ? (wd >> 16) : (wd & 0xffffu)); } }
                loaded_hi += nnew;
                qf0 = nq0; qf1 = nq1; ml = nml;
#pragma unroll
                for (int dt = 0; dt < 4; ++dt) po[dt] = no[dt];
                __syncthreads();
            }
        }
    }
    __syncthreads();
}

#define XB_TMO      128
#define XB_XCNT(j)  (256  + 64 * (j))
#define XB_XSUB(j)  (1280 + 64 * (j))
#define XB_XGEN(j)  (2304 + 64 * (j))
#define XB_TOP      3328
#define XB_TOPGEN   3392
#define XCD_BAR_WORDS 3456
#define XB_SPIN_CAP (1u << 18)
__device__ __forceinline__ unsigned xb_ld(unsigned* p)              { return __hip_atomic_load(p, __ATOMIC_RELAXED, __HIP_MEMORY_SCOPE_AGENT); }
__device__ __forceinline__ unsigned xb_add(unsigned* p, unsigned v) { return __hip_atomic_fetch_add(p, v, __ATOMIC_RELAXED, __HIP_MEMORY_SCOPE_AGENT); }
__device__ __forceinline__ unsigned xb_xcc_id() { return (unsigned)__builtin_amdgcn_s_getreg((3 << 11) | 20) & 0xFu; }
#define XB_SPIN(cond, bar) do { unsigned _sp = 0; while (cond) { __builtin_amdgcn_s_sleep(1); \
    if ((++_sp & 255u) == 0u) { if (xb_ld(&(bar)[XB_TMO])) break; if (_sp > XB_SPIN_CAP) { atomicAdd(&(bar)[XB_TMO], 1u); break; } } } } while (0)
struct XcdBarrier { unsigned* bar; unsigned x; volatile __attribute__((address_space(3))) unsigned* st; };
__device__ __forceinline__ XcdBarrier xcd_barrier_post(unsigned* bar, volatile __attribute__((address_space(3))) unsigned* st) {
    XcdBarrier b; b.bar = bar; b.x = xb_xcc_id(); b.st = st;
    if (threadIdx.x == 0) (void)xb_add(&bar[XB_XCNT(b.x)], 1u);
    return b;
}
__device__ __forceinline__ void xcd_barrier_complete(unsigned* bar, unsigned x, unsigned& nloc, unsigned& nx) {
    const unsigned G = gridDim.x * gridDim.y * gridDim.z;
    unsigned sum, cnt, mine, sp = 0u;
    for (;;) {
        sum = 0u; cnt = 0u; mine = 0u;
#pragma unroll
        for (unsigned j = 0; j < 16; ++j) { const unsigned c = xb_ld(&bar[XB_XCNT(j)]); sum += c; cnt += (c > 0u) ? 1u : 0u; mine = (j == x) ? c : mine; }
        if (sum == G) break;
        __builtin_amdgcn_s_sleep(1);
        if ((++sp & 255u) == 0u) { if (xb_ld(&bar[XB_TMO])) break; if (sp > XB_SPIN_CAP) { atomicAdd(&bar[XB_TMO], 1u); break; } }
    }
    nloc = mine > 0u ? mine : 1u; nx = cnt > 0u ? cnt : 1u;
}
__device__ __forceinline__ void xcd_barrier(const XcdBarrier& b) {
    asm volatile("s_waitcnt vmcnt(0)" ::: "memory");
    __syncthreads();
    if (threadIdx.x == 0) {
        unsigned* bar = b.bar;
        __builtin_amdgcn_s_waitcnt(0);
        unsigned nloc = b.st[0], nx = b.st[1];
        if (nloc == 0u) { xcd_barrier_complete(bar, b.x, nloc, nx); b.st[0] = nloc; b.st[1] = nx; }
        const unsigned old = xb_add(&bar[XB_XSUB(b.x)], 1u);
        const unsigned gen = old / nloc;
        if (old + 1u == (gen + 1u) * nloc) {
            __builtin_amdgcn_fence(__ATOMIC_RELEASE, "agent");
            asm volatile("s_waitcnt vmcnt(0)" ::: "memory");
            const unsigned og = xb_add(&bar[XB_TOP], 1u);
            const unsigned tg = og / nx;
            if (og + 1u == (tg + 1u) * nx) xb_add(&bar[XB_TOPGEN], 1u);
            else XB_SPIN(xb_ld(&bar[XB_TOPGEN]) == tg, bar);
            __builtin_amdgcn_fence(__ATOMIC_ACQUIRE, "agent");
            xb_add(&bar[XB_XGEN(b.x)], 1u);
            asm volatile("s_waitcnt vmcnt(0)" ::: "memory");
        } else {
            XB_SPIN(xb_ld(&bar[XB_XGEN(b.x)]) == gen, bar);
            __builtin_amdgcn_fence(__ATOMIC_ACQUIRE, "agent");
            asm volatile("s_waitcnt vmcnt(0)" ::: "memory");
        }
    }
    __syncthreads();
}

#define LAS __attribute__((address_space(3)))
constexpr int NWAVES = 8, NTHR = 512;
constexpr int LDS_BYTES = 163840;
constexpr size_t WS_WIN = 2 * MiB, WS_WOUT = 9 * MiB, WS_W1 = 11 * MiB, WS_W2 = 19 * MiB;

struct Args { const float* in[17]; float* out; unsigned char* ws; int ph_lo, ph_hi; };


__device__ __forceinline__ void transpose_item(const float* __restrict__ W, int K, int N, bf16_t* __restrict__ WT, LAS float* scr, int item, int lane) {
    const int nblk = N / 32, kb = item / nblk, nb = item % nblk, k0 = 64 * kb, n0 = 32 * nb;
#pragma unroll 8
    for (int i = 0; i < 32; ++i) { const int kk = 2 * i + (lane >> 5); scr[kk * 33 + (lane & 31)] = W[(size_t)(k0 + kk) * N + n0 + (lane & 31)]; }
    asm volatile("s_waitcnt lgkmcnt(0)" ::: "memory");
    const int c = lane & 7;
#pragma unroll
    for (int j = 0; j < 4; ++j) { const int n = (lane >> 3) + 8 * j; const LAS float* s = scr + (8 * c) * 33 + n;
        u32x4 o; o.x = pk2(s[0 * 33], s[1 * 33]); o.y = pk2(s[2 * 33], s[3 * 33]); o.z = pk2(s[4 * 33], s[5 * 33]); o.w = pk2(s[6 * 33], s[7 * 33]);
        *(u32x4*)(WT + (size_t)(n0 + n) * K + k0 + 8 * c) = o; }
    asm volatile("s_waitcnt lgkmcnt(0)" ::: "memory");
}

__global__ void __launch_bounds__(NTHR, 2) mega(Args args) {
    extern __shared__ __attribute__((aligned(16))) unsigned char lds_raw[];
    LAS unsigned char* lds = (LAS unsigned char*)lds_raw;
    const int tid = threadIdx.x, lane = tid & 63, wave = __builtin_amdgcn_readfirstlane(tid >> 6);
    const int G = gridDim.x, bx = blockIdx.x;
    const int gw = bx * NWAVES + wave, NGW = G * NWAVES;
    const int vcu = (G % 8 == 0) ? (bx % 8) * (G / 8) + bx / 8 : bx;
    const int lo = args.ph_lo, hi = args.ph_hi;
    unsigned char* ws = args.ws;
    const float* x = args.in[0]; const float* c = args.in[1]; const float* ctx = args.in[2]; const float* c_ctx = args.in[3];
    const float* w_ada = args.in[4]; const float* b_ada = args.in[5];
    const float* g_pre_mix = args.in[6]; const float* g_post_mix = args.in[7]; const float* g_pre_mlp = args.in[8]; const float* g_post_mlp = args.in[9];
    const float* w_in = args.in[10]; const float* w_out = args.in[14]; const float* w_mlp1 = args.in[15]; const float* w_mlp2 = args.in[16];
    float* out = args.out;
    float* MOD = (float*)(ws + WS_MOD); bf16_t* XN = (bf16_t*)(ws + WS_XN); bf16_t* QKV = (bf16_t*)(ws + WS_QKV); bf16_t* HID = (bf16_t*)(ws + WS_HID);
    bf16_t* MIX = (bf16_t*)(ws + WS_MIX); float* Y = (float*)(ws + WS_Y); bf16_t* H2 = XN;
    bf16_t* WinT = (bf16_t*)(ws + WS_WIN); bf16_t* WoutT = (bf16_t*)(ws + WS_WOUT); bf16_t* W1T = (bf16_t*)(ws + WS_W1); bf16_t* W2T = (bf16_t*)(ws + WS_W2);
#define IN(k) (lo <= (k) && (k) < hi)
    volatile LAS unsigned* stw = (volatile LAS unsigned*)(lds + LDS_BYTES - 64);
    if (tid < 2) stw[tid] = 0u;
    __syncthreads();
    XcdBarrier xbar = xcd_barrier_post((unsigned*)ws, stw);
    if (lo < 0) cg::this_grid().sync();
#define GSYNC() xcd_barrier(xbar)
#define SEAM(k) do { if (IN(k) && IN((k) + 1)) GSYNC(); } while (0)

    if (IN(0)) {
        if (bx < 96) {
            LAS float* sl = (LAS float*)lds;
            LAS float* red = (LAS float*)(lds + 72 * 1024);
            for (int e = tid; e < 17 * 1024; e += NTHR) { const float v = e < 16 * 1024 ? c[e] : c_ctx[e - 16 * 1024]; sl[e] = v / (1.f + expf(-v)); }
            __syncthreads();
            const int col = bx * 64 + lane;
            float acc[17];
#pragma unroll
            for (int r = 0; r < 17; ++r) acc[r] = 0.f;
            for (int k0 = wave * 128; k0 < wave * 128 + 128; k0 += 16) {
                float wv[16];
#pragma unroll
                for (int u = 0; u < 16; ++u) wv[u] = w_ada[(size_t)(k0 + u) * 6144 + col];
#pragma unroll
                for (int u = 0; u < 16; ++u)
#pragma unroll
                    for (int r = 0; r < 17; ++r) acc[r] += sl[r * 1024 + k0 + u] * wv[u];
            }
#pragma unroll
            for (int r = 0; r < 17; ++r) red[(wave * 17 + r) * 64 + lane] = acc[r];
            __syncthreads();
            for (int e = tid; e < 17 * 64; e += NTHR) { const int r = e >> 6, cc = e & 63; float s = b_ada[bx * 64 + cc];
#pragma unroll
                for (int w = 0; w < 8; ++w) s += red[(w * 17 + r) * 64 + cc];
                MOD[r * 6144 + bx * 64 + cc] = s; }
            __syncthreads();
        }
        if (bx == G - 1) { float* ROPE = (float*)(ws + WS_ROPE);
            for (int e = tid; e < 64 * 32; e += NTHR) { const float inv = exp2f(-(float)(e & 31) * (13.287712379549449f / 32.f)); const float ang = (float)(e >> 5) * inv; ROPE[e] = cosf(ang); ROPE[2048 + e] = sinf(ang); } }
        LAS float* scr = (LAS float*)(lds + wave * 16384);
        constexpr int I_IN = (D / 64) * (INW / 32), I_O = (D / 64) * (D / 32), I_1 = (D / 64) * (FF / 32), I_2 = (FF / 64) * (D / 32);
        for (int it = gw; it < I_IN + I_O + I_1 + I_2; it += NGW) {
            int r = it;
            if (r < I_IN) { transpose_item(w_in, D, INW, WinT, scr, r, lane); continue; } r -= I_IN;
            if (r < I_O) { transpose_item(w_out, D, D, WoutT, scr, r, lane); continue; } r -= I_O;
            if (r < I_1) { transpose_item(w_mlp1, D, FF, W1T, scr, r, lane); continue; } r -= I_1;
            transpose_item(w_mlp2, FF, D, W2T, scr, r, lane);
        }
    }
    SEAM(0);
    if (IN(1)) {
        const int rpw = (MT + NGW - 1) / NGW, r0 = gw * rpw, r1 = min(MT, r0 + rpw);
        int curb = -1; f32x4 Bc[4], Cc[4], v[4], nv[4];
        if (r0 < r1) { const float* src = r0 < ML ? x + (size_t)r0 * D : ctx + (size_t)(r0 - ML) * D;
#pragma unroll
            for (int j = 0; j < 4; ++j) v[j] = *(const f32x4*)(src + 256 * j + 4 * lane); }
        for (int row = r0; row < r1; ++row) {
            if (row + 1 < r1) { const int rn = row + 1; const float* src = rn < ML ? x + (size_t)rn * D : ctx + (size_t)(rn - ML) * D;
#pragma unroll
                for (int j = 0; j < 4; ++j) nv[j] = *(const f32x4*)(src + 256 * j + 4 * lane); }
            const int b = row < ML ? row / SEQ : 16;
            if (b != curb) { curb = b; const float* sh = MOD + b * 6144; const float* sc = sh + 1024;
#pragma unroll
                for (int j = 0; j < 4; ++j) { const int col = 256 * j + 4 * lane; Bc[j] = *(const f32x4*)(g_pre_mix + col) * (*(const f32x4*)(sc + col) + 1.f); Cc[j] = *(const f32x4*)(sh + col); } }
            float ss = 0.f;
#pragma unroll
            for (int j = 0; j < 4; ++j) ss += v[j].x * v[j].x + v[j].y * v[j].y + v[j].z * v[j].z + v[j].w * v[j].w;
            const float r = rsqrtf(wave_sum(ss) * (1.f / D) + EPS);
#pragma unroll
            for (int j = 0; j < 4; ++j) {
                const f32x4 o = v[j] * r * Bc[j] + Cc[j];
                u32x2 pk; pk.x = pk2(o.x, o.y); pk.y = pk2(o.z, o.w);
                *(u32x2*)(XN + (size_t)row * D + 256 * j + 4 * lane) = pk;
            }
#pragma unroll
            for (int j = 0; j < 4; ++j) v[j] = nv[j];
        }
    }
    SEAM(1);
    if (IN(2)) {
        pg8::Gemm g{XN, WinT, MT, INW, D}; pg8::StaticOrder S; S.init(MT, INW, G, bx);
        pg8::EpiBf16<0> E{QKV, INW};
        pg8::gemm_phase(lds, g, S, E);
    }
    SEAM(2);
    if (IN(4)) {
        ret_phase(lds, QKV, args.in[11], (const float*)(ws + WS_ROPE), (bf16_t*)(ws + WS_RPF), (bf16_t*)(ws + WS_RPB), G, vcu);
        __syncthreads();
        na2_phase(lds, QKV, args.in[13], MIX, out, out + (size_t)ML * 8 * 64, G, vcu);
    }
    if (IN(4) && IN(5)) GSYNC();
    if (IN(4)) ret_combine((const bf16_t*)(ws + WS_RPF), (const bf16_t*)(ws + WS_RPB), QKV, args.in[12], MIX, gw, NGW, lane);
    SEAM(4);
    if (IN(5)) {
        pg8::Gemm g{MIX, WoutT, ML, D, D}; pg8::StaticOrder S; S.init(ML, D, G, bx);
        pg8::EpiBf16<0> E{(bf16_t*)(ws + WS_RPB), D};
        pg8::gemm_phase(lds, g, S, E);
    }
    SEAM(5);
    if (IN(6)) {
        const bf16_t* T = (const bf16_t*)(ws + WS_RPB);
        {
        bf16_t* H2w = H2;
        const int rpw = (ML + NGW - 1) / NGW, r0 = gw * rpw, r1 = min(ML, r0 + rpw);
        int curb = -1; f32x4 Ac[4], Bc[4], Cc[4], xv[4], nx[4]; u32x2 tv[4], nt[4];
        if (r0 < r1) {
#pragma unroll
            for (int j = 0; j < 4; ++j) { tv[j] = *(const u32x2*)(T + (size_t)r0 * D + 256 * j + 4 * lane); xv[j] = *(const f32x4*)(x + (size_t)r0 * D + 256 * j + 4 * lane); } }
        for (int row = r0; row < r1; ++row) {
            if (row + 1 < r1) {
#pragma unroll
                for (int j = 0; j < 4; ++j) { nt[j] = *(const u32x2*)(T + (size_t)(row + 1) * D + 256 * j + 4 * lane); nx[j] = *(const f32x4*)(x + (size_t)(row + 1) * D + 256 * j + 4 * lane); } }
            const int b = row / SEQ;
            if (b != curb) { curb = b; const float* md = MOD + b * 6144;
#pragma unroll
                for (int j = 0; j < 4; ++j) { const int col = 256 * j + 4 * lane; Ac[j] = *(const f32x4*)(md + 2048 + col) * *(const f32x4*)(g_post_mix + col);
                    Bc[j] = *(const f32x4*)(g_pre_mlp + col) * (*(const f32x4*)(md + 4096 + col) + 1.f); Cc[j] = *(const f32x4*)(md + 3072 + col); } }
            f32x4 t[4]; float ss = 0.f;
#pragma unroll
            for (int j = 0; j < 4; ++j) { t[j] = (f32x4){__uint_as_float(tv[j].x << 16), __uint_as_float(tv[j].x & 0xffff0000u), __uint_as_float(tv[j].y << 16), __uint_as_float(tv[j].y & 0xffff0000u)};
                ss += t[j].x * t[j].x + t[j].y * t[j].y + t[j].z * t[j].z + t[j].w * t[j].w; }
            const float r = rsqrtf(wave_sum(ss) * (1.f / D) + EPS);
            float ss2 = 0.f;
#pragma unroll
            for (int j = 0; j < 4; ++j) { t[j] = xv[j] + Ac[j] * (t[j] * r); ss2 += t[j].x * t[j].x + t[j].y * t[j].y + t[j].z * t[j].z + t[j].w * t[j].w;
                }
            const float r2 = rsqrtf(wave_sum(ss2) * (1.f / D) + EPS);
#pragma unroll
            for (int j = 0; j < 4; ++j) { const f32x4 o = t[j] * r2 * Bc[j] + Cc[j]; u32x2 pk; pk.x = pk2(o.x, o.y); pk.y = pk2(o.z, o.w);
                *(u32x2*)(H2w + (size_t)row * D + 256 * j + 4 * lane) = pk; }
#pragma unroll
            for (int j = 0; j < 4; ++j) { tv[j] = nt[j]; xv[j] = nx[j]; }
        }
        }
    }
    SEAM(6);
    if (IN(7)) {
        pg8::Gemm g{H2, W1T, ML, FF, D}; pg8::StaticOrder S; S.init(ML, FF, G, bx);
        pg8::EpiBf16<1> E{HID, FF};
        pg8::gemm_phase(lds, g, S, E);
    }
    SEAM(7);
    if (IN(8)) {
        pg8::Gemm g{HID, W2T, ML, D, FF}; pg8::StaticOrder S; S.init(ML, D, G, bx);
        pg8::EpiBf16<0> E{(bf16_t*)Y, D};
        pg8::gemm_phase(lds, g, S, E);
    }
    SEAM(8);
    if (IN(9)) {
        const bf16_t* Yb = (const bf16_t*)Y; const bf16_t* T = (const bf16_t*)(ws + WS_RPB);
        {
        float* outw = out;
        const int rpw = (ML + NGW - 1) / NGW, r0 = gw * rpw, r1 = min(ML, r0 + rpw);
        int curb = -1; f32x4 A1[4], A2[4], xv[4], nx[4]; u32x2 tv[4], nt[4], yv[4], ny[4];
        if (r0 < r1) {
#pragma unroll
            for (int j = 0; j < 4; ++j) { const size_t o_ = (size_t)r0 * D + 256 * j + 4 * lane; tv[j] = *(const u32x2*)(T + o_); yv[j] = *(const u32x2*)(Yb + o_); xv[j] = *(const f32x4*)(x + o_); } }
        for (int row = r0; row < r1; ++row) {
            if (row + 1 < r1) {
#pragma unroll
                for (int j = 0; j < 4; ++j) { const size_t o_ = (size_t)(row + 1) * D + 256 * j + 4 * lane; nt[j] = *(const u32x2*)(T + o_); ny[j] = *(const u32x2*)(Yb + o_); nx[j] = *(const f32x4*)(x + o_); } }
            const int b = row / SEQ;
            if (b != curb) { curb = b; const float* md = MOD + b * 6144;
#pragma unroll
                for (int j = 0; j < 4; ++j) { const int col = 256 * j + 4 * lane; A1[j] = *(const f32x4*)(md + 2048 + col) * *(const f32x4*)(g_post_mix + col); A2[j] = *(const f32x4*)(md + 5120 + col) * *(const f32x4*)(g_post_mlp + col); } }
            f32x4 t[4], y[4]; float ss = 0.f, sy = 0.f;
#pragma unroll
            for (int j = 0; j < 4; ++j) { t[j] = (f32x4){__uint_as_float(tv[j].x << 16), __uint_as_float(tv[j].x & 0xffff0000u), __uint_as_float(tv[j].y << 16), __uint_as_float(tv[j].y & 0xffff0000u)};
                y[j] = (f32x4){__uint_as_float(yv[j].x << 16), __uint_as_float(yv[j].x & 0xffff0000u), __uint_as_float(yv[j].y << 16), __uint_as_float(yv[j].y & 0xffff0000u)};
                ss += t[j].x * t[j].x + t[j].y * t[j].y + t[j].z * t[j].z + t[j].w * t[j].w; sy += y[j].x * y[j].x + y[j].y * y[j].y + y[j].z * y[j].z + y[j].w * y[j].w; }
            const float r = rsqrtf(wave_sum(ss) * (1.f / D) + EPS), ry = rsqrtf(wave_sum(sy) * (1.f / D) + EPS);
#pragma unroll
            for (int j = 0; j < 4; ++j) { const f32x4 x1 = xv[j] + A1[j] * (t[j] * r); *(f32x4*)(outw + (size_t)row * D + 256 * j + 4 * lane) = x1 + A2[j] * (y[j] * ry); }
#pragma unroll
            for (int j = 0; j < 4; ++j) { tv[j] = nt[j]; yv[j] = ny[j]; xv[j] = nx[j]; }
        }
        }
    }
#undef IN
#undef SEAM
}

static void launch_mega(Args a, int lo, int hi, int grid, hipStream_t stream) {
    a.ph_lo = lo; a.ph_hi = hi;
    if (hi - lo > 1) {
        void* kargs[] = {&a};
        hipError_t e = hipLaunchCooperativeKernel((const void*)mega, dim3(grid), dim3(NTHR), kargs, LDS_BYTES, stream);
        if (e != hipSuccess) fprintf(stderr, "cooperative launch failed: %s (grid %d)\n", hipGetErrorString(e), grid);
    } else {
        hipLaunchKernelGGL(mega, dim3(grid), dim3(NTHR), LDS_BYTES, stream, a);
    }
}

extern "C" void kernel_launch(void* const* d_in, const int* in_sizes, int n_in, void* d_out, int out_size, void* d_ws, size_t ws_size, hipStream_t stream) {
    static int grid = 0;
    if (grid == 0) {
        if (ws_size < WS_END || n_in != 17) { fprintf(stderr, "kernel_launch: bad ws/n_in: %zu %d\n", ws_size, n_in); grid = -1; return; }
        int dev = 0, cus = 0, per_cu = 0;
        (void)hipGetDevice(&dev); (void)hipDeviceGetAttribute(&cus, hipDeviceAttributeMultiprocessorCount, dev);
        if (hipFuncSetAttribute((const void*)mega, hipFuncAttributeMaxDynamicSharedMemorySize, LDS_BYTES) != hipSuccess) { fprintf(stderr, "hipFuncSetAttribute failed\n"); grid = -1; return; }
        if (hipOccupancyMaxActiveBlocksPerMultiprocessor(&per_cu, (const void*)mega, NTHR, LDS_BYTES) != hipSuccess || per_cu < 1) { fprintf(stderr, "occupancy query: %d\n", per_cu); per_cu = 1; }
        (void)hipGetLastError();
        grid = (cus > 0 ? cus : 256) * 1;
    }
    if (grid < 0) return;
    Args a{};
    for (int i = 0; i < 17; ++i) a.in[i] = (const float*)d_in[i];
    a.out = (float*)d_out; a.ws = (unsigned char*)d_ws;
    (void)hipMemsetAsync(d_ws, 0, 16384, stream);
    launch_mega(a, 0, 10, grid, stream);
}
```

```cpp
#include <hip/hip_runtime.h>
#include <cstdint>
#include <cstdio>
#include <hip/hip_cooperative_groups.h>
namespace cg = cooperative_groups;

typedef unsigned short bf16_t;
typedef unsigned u32x4 __attribute__((ext_vector_type(4)));
typedef float f32x4 __attribute__((ext_vector_type(4)));

constexpr int D = 1024, NB = 16, SEQ = 2048, CTX = 256, ML = NB * SEQ, MC = NB * CTX, MT = ML + MC;
constexpr int INW = 3584, FF = 4096;
constexpr int C_RQ = 0, C_RK = 512, C_RV = 1024, C_RG = 1536, C_NQ = 2048, C_NK = 2560, C_NV = 3072;
constexpr float EPS = 1e-6f;
constexpr size_t MiB = 1u << 20;
constexpr size_t WS_MOD = 1 * MiB, WS_XN = 32 * MiB, WS_QKV = 104 * MiB, WS_HID = 104 * MiB, WS_MIX = 360 * MiB, WS_Y = 360 * MiB, WS_END = 488 * MiB;

__device__ __forceinline__ float bf2f(bf16_t v) { return __uint_as_float(((unsigned)v) << 16); }
__device__ __forceinline__ bf16_t f2bf(float f) { unsigned u = __float_as_uint(f); return (bf16_t)((u + 0x7fffu + ((u >> 16) & 1u)) >> 16); }
__device__ __forceinline__ float wave_sum(float v) {
#pragma unroll
    for (int o = 1; o < 64; o <<= 1) v += __shfl_xor(v, o);
    return v;
}
__device__ __forceinline__ float wave_max(float v) {
#pragma unroll
    for (int o = 1; o < 64; o <<= 1) v = fmaxf(v, __shfl_xor(v, o));
    return v;
}
typedef float f32x2_t __attribute__((ext_vector_type(2)));
typedef __bf16 bf16x2_t __attribute__((ext_vector_type(2)));
__device__ __forceinline__ unsigned pk2(float lo, float hi) { f32x2_t v = {lo, hi}; bf16x2_t b = __builtin_convertvector(v, bf16x2_t); return __builtin_bit_cast(unsigned, b); }
__device__ __forceinline__ float siluf(float v) { return v / (1.f + __expf(-v)); }

namespace pg8 {
#define PG8_LAS __attribute__((address_space(3)))
typedef short bf16x8 __attribute__((ext_vector_type(8)));
constexpr int BM = 256, BK = 64, HALF = 128, HTB = HALF * BK * 2, STAGE_BYTES = 8 * HTB, NXCD = 8, WGM = 8;
__host__ __device__ __forceinline__ int lds_byte(int r, int c) { const int st = (r >> 4) * 2 + (c >> 5), rr = r & 15, cc = c & 31, ob = rr * 64 + cc * 2; return st * 1024 + (ob ^ (((ob >> 9) & 1) << 5)); }
__host__ __device__ __forceinline__ void stage_rc(int b, int& R, int& C) { const int st = b / 1024, sb = b % 1024, swz = sb ^ (((sb >> 9) & 1) << 5); R = (st >> 1) * 16 + swz / 64; C = (st & 1) * 32 + (swz % 64) / 2; }
__host__ __device__ __forceinline__ int perm32(int rho) { const int n = rho >> 4, i = rho & 15; return 8 * (i >> 2) + 4 * n + (i & 3); }
struct Unit { int pm, pn; };
struct Gemm { const bf16_t* A; const bf16_t* Bt; int M, N, K; };
struct StaticOrder {
    int nM, nN, nwg, G, c;
    __host__ __device__ void init(int M, int N, int G_, int c_) { nM = M / BM; nN = N / BM; nwg = nM * nN; G = G_; c = c_; }
    __host__ __device__ bool next(int i, Unit& u) const {
        const long L = (long)i * G + c; if (L >= nwg) return false;
        int wgid = (int)L; { const int q = nwg / NXCD, r = nwg % NXCD, xcd = wgid % NXCD, off = wgid / NXCD; wgid = (xcd < r ? xcd * (q + 1) : r * (q + 1) + (xcd - r) * q) + off; }
        const int nig = WGM * nN, gid = wgid / nig, fm = gid * WGM, gsz = (nM - fm) < WGM ? (nM - fm) : WGM;
        u.pm = fm + ((wgid % nig) % gsz); u.pn = (wgid % nig) / gsz; return true;
    }
};
__device__ __forceinline__ unsigned cvt_pk_bf16(float lo, float hi) { unsigned r; asm volatile("v_cvt_pk_bf16_f32 %0, %1, %2" : "=v"(r) : "v"(lo), "v"(hi)); return r; }

template <int ACT  > struct EpiBf16 {
    static constexpr bool PERM = true;
    bf16_t* O; int ldc;
    __device__ __forceinline__ void operator()(const f32x4 (&acc)[2][2][4][2], const Unit& u, int wr, int wc, int fr, int fq) const {
        const int row0 = u.pm * BM + wr * 64 + fr; const int col0 = u.pn * BM + wc * 32 + 8 * fq;
#pragma unroll
        for (int ai = 0; ai < 2; ++ai)
#pragma unroll
            for (int m = 0; m < 4; ++m) { bf16_t* rowp = O + (size_t)(row0 + ai * HALF + m * 16) * ldc + col0;
#pragma unroll
                for (int bj = 0; bj < 2; ++bj) { f32x4 v0 = acc[ai][bj][m][0], v1 = acc[ai][bj][m][1];
                    if (ACT == 1) {
#pragma unroll
                        for (int e = 0; e < 4; ++e) { float a = fmaxf(v0[e], 0.f); v0[e] = a * a; float b = fmaxf(v1[e], 0.f); v1[e] = b * b; } }
                    u32x4 w; w.x = cvt_pk_bf16(v0[0], v0[1]); w.y = cvt_pk_bf16(v0[2], v0[3]); w.z = cvt_pk_bf16(v1[0], v1[1]); w.w = cvt_pk_bf16(v1[2], v1[3]);
                    __builtin_nontemporal_store(w, (u32x4*)(rowp + bj * HALF)); } }
    }
};
template <class Epi, class Sched>
__device__ __forceinline__ void gemm_phase(PG8_LAS unsigned char* lds, const Gemm g, const Sched& S, const Epi& E) {
    const int tid = threadIdx.x, wid = __builtin_amdgcn_readfirstlane(tid >> 6), lane = tid & 63, wr = wid >> 2, wc = wid & 3, fr = lane & 15, fq = lane >> 4;
    const int K = g.K, nt = K / BK;
    unsigned voffA[2], voffB[2];
#pragma unroll
    for (int i = 0; i < 2; ++i) { int R, C; stage_rc(tid * 16 + i * 8192, R, C); const int Rb = Epi::PERM ? ((R & ~31) + perm32(R & 31)) : R;
        voffA[i] = (unsigned)(R * K + C) * 2u; voffB[i] = (unsigned)(Rb * K + C) * 2u; }
    const size_t kstep = (size_t)(BK * 2);
    const size_t hstep = (size_t)HALF * K * 2;
    const size_t tstep = 2 * hstep;
    const unsigned ldsw = (unsigned)wid * 1024u;
    const int aoff = lds_byte(wr * 64 + fr, fq * 8), boff = lds_byte(wc * 32 + fr, fq * 8);
#define PG8_SA(b, h) (((b) * 2 + (h)) * HTB)
#define PG8_SB(b, h) ((4 + (b) * 2 + (h)) * HTB)
#define PG8_STAGE(bufoff, gbase, voff) do { _Pragma("unroll") for (int _i = 0; _i < 2; ++_i) \
        __builtin_amdgcn_global_load_lds((const unsigned*)((const char*)(gbase) + (voff)[_i]), (PG8_LAS unsigned*)(lds + (bufoff) + ldsw + _i * 8192), 16, 0, 0); } while (0)
#define PG8_LDA(dst, b, h) do { _Pragma("unroll") for (int m = 0; m < 4; ++m) _Pragma("unroll") for (int k = 0; k < 2; ++k) dst[m][k] = *(const PG8_LAS bf16x8*)(lds + PG8_SA(b, h) + aoff + m * 2048 + k * 1024); } while (0)
#define PG8_LDB(dst, b, h) do { _Pragma("unroll") for (int n = 0; n < 2; ++n) _Pragma("unroll") for (int k = 0; k < 2; ++k) dst[n][k] = *(const PG8_LAS bf16x8*)(lds + PG8_SB(b, h) + boff + n * 2048 + k * 1024); } while (0)
#define PG8_MMA(ai, bj, At, Bt) do { __builtin_amdgcn_s_setprio(1); _Pragma("unroll") for (int m = 0; m < 4; ++m) _Pragma("unroll") for (int n = 0; n < 2; ++n) _Pragma("unroll") for (int k = 0; k < 2; ++k) \
        acc[ai][bj][m][n] = __builtin_amdgcn_mfma_f32_16x16x32_bf16(Bt[n][k], At[m][k], acc[ai][bj][m][n], 0, 0, 0); __builtin_amdgcn_s_setprio(0); } while (0)
#define PG8_WAIT_V(n) asm volatile("s_waitcnt vmcnt(" #n ")" ::: "memory")
#define PG8_WAIT_L(n) asm volatile("s_waitcnt lgkmcnt(" #n ")" ::: "memory")
#define PG8_BAR __builtin_amdgcn_s_barrier()
#define PG8_SCHED __builtin_amdgcn_sched_barrier(0)
    Unit cur, nxt; int ui = 0;
    if (!S.next(0, cur)) return;
    f32x4 acc[2][2][4][2];
#pragma unroll
    for (int a = 0; a < 2; ++a)
#pragma unroll
        for (int b = 0; b < 2; ++b)
#pragma unroll
            for (int m = 0; m < 4; ++m)
#pragma unroll
                for (int n = 0; n < 2; ++n) acc[a][b][m][n] = (f32x4){0.f, 0.f, 0.f, 0.f};
    bf16x8 At[4][2], B0[2][2], B1[2][2];
    const char* cA = (const char*)g.A + (size_t)cur.pm * tstep; const char* cB = (const char*)g.Bt + (size_t)cur.pn * tstep;
    PG8_STAGE(PG8_SB(0, 0), cB, voffB); PG8_STAGE(PG8_SB(0, 1), cB + hstep, voffB); PG8_STAGE(PG8_SA(0, 0), cA, voffA); PG8_STAGE(PG8_SA(0, 1), cA + hstep, voffA);
    if (wr == 1) PG8_BAR;
    PG8_WAIT_V(2); PG8_BAR;
    PG8_STAGE(PG8_SB(1, 0), cB + kstep, voffB); PG8_STAGE(PG8_SA(1, 0), cA + kstep, voffA); PG8_STAGE(PG8_SB(1, 1), cB + hstep + kstep, voffB);
    PG8_WAIT_V(6); PG8_BAR;
    for (;;) {
        const bool has_next = S.next(ui + 1, nxt);
        const char* nA = has_next ? (const char*)g.A + (size_t)nxt.pm * tstep : cA; const char* nB = has_next ? (const char*)g.Bt + (size_t)nxt.pn * tstep : cB;
        for (int t = 0; t < nt; t += 2) {
            const bool last = (t == nt - 2);
            const char* a1 = cA + (size_t)(t + 1) * kstep;
            const char* a2 = last ? nA : cA + (size_t)(t + 2) * kstep; const char* b2 = last ? nB : cB + (size_t)(t + 2) * kstep;
            const char* a3 = a2 + kstep; const char* b3 = b2 + kstep;
            PG8_LDB(B0, 0, 0); PG8_LDB(B1, 0, 1); PG8_SCHED; PG8_LDA(At, 0, 0); PG8_STAGE(PG8_SA(1, 1), a1 + hstep, voffA);
            PG8_WAIT_V(8); PG8_WAIT_L(0); PG8_BAR; PG8_MMA(0, 0, At, B0); PG8_MMA(0, 1, At, B1); PG8_BAR; PG8_SCHED;
            PG8_LDA(At, 0, 1); PG8_STAGE(PG8_SB(0, 0), b2, voffB); PG8_STAGE(PG8_SB(0, 1), b2 + hstep, voffB); PG8_STAGE(PG8_SA(0, 0), a2, voffA);
            PG8_WAIT_V(8); PG8_WAIT_L(0); PG8_BAR; PG8_MMA(1, 0, At, B0); PG8_MMA(1, 1, At, B1); PG8_BAR; PG8_SCHED;
            PG8_LDB(B0, 1, 0); PG8_LDB(B1, 1, 1); PG8_SCHED; PG8_LDA(At, 1, 0); PG8_STAGE(PG8_SA(0, 1), a2 + hstep, voffA);
            PG8_WAIT_V(8); PG8_WAIT_L(0); PG8_BAR; PG8_MMA(0, 0, At, B0); PG8_MMA(0, 1, At, B1); PG8_BAR; PG8_SCHED;
            PG8_LDA(At, 1, 1); PG8_STAGE(PG8_SB(1, 0), b3, voffB); PG8_STAGE(PG8_SB(1, 1), b3 + hstep, voffB); PG8_STAGE(PG8_SA(1, 0), a3, voffA);
            PG8_WAIT_V(8); PG8_WAIT_L(0); PG8_BAR; PG8_MMA(1, 0, At, B0); PG8_MMA(1, 1, At, B1); PG8_BAR; PG8_SCHED;
        }
        if (wr == 0) PG8_BAR;
        E(acc, cur, wr, wc, fr, fq);
        if (!has_next) break;
#pragma unroll
        for (int a = 0; a < 2; ++a)
#pragma unroll
            for (int b = 0; b < 2; ++b)
#pragma unroll
                for (int m = 0; m < 4; ++m)
#pragma unroll
                    for (int n = 0; n < 2; ++n) acc[a][b][m][n] = (f32x4){0.f, 0.f, 0.f, 0.f};
        cur = nxt; cA = nA; cB = nB; ++ui;
        if (wr == 1) PG8_BAR;
    }
    PG8_WAIT_V(0);
    PG8_BAR;
#undef PG8_SA
#undef PG8_SB
#undef PG8_STAGE
#undef PG8_LDA
#undef PG8_LDB
#undef PG8_MMA
#undef PG8_WAIT_V
#undef PG8_WAIT_L
#undef PG8_BAR
#undef PG8_SCHED
}
}


typedef short bf16x8_t __attribute__((ext_vector_type(8)));
typedef unsigned u32x2 __attribute__((ext_vector_type(2)));
#define MLAS __attribute__((address_space(3)))
#define MFMA16(a, b, c) __builtin_amdgcn_mfma_f32_16x16x32_bf16((a), (b), (c), 0, 0, 0)
constexpr int NTHR_ = 512;
constexpr size_t WS_UF = 32 * MiB, WS_UB = 424 * MiB;
constexpr size_t WS_RPF = 32 * MiB, WS_RPB = 424 * MiB, WS_ROPE = 1 * MiB + 512 * 1024;

__device__ __forceinline__ void rope_pair(u32x4& a, u32x4& b, const f32x4 c0, const f32x4 c1, const f32x4 s0, const f32x4 s1) {
    u32x4 oa, ob;
#pragma unroll
    for (int e = 0; e < 4; ++e) {
        const float x1l = __uint_as_float(a[e] << 16), x1h = __uint_as_float(a[e] & 0xffff0000u), x2l = __uint_as_float(b[e] << 16), x2h = __uint_as_float(b[e] & 0xffff0000u);
        const float cl = e < 2 ? c0[2 * e] : c1[2 * e - 4], ch = e < 2 ? c0[2 * e + 1] : c1[2 * e - 3], sl = e < 2 ? s0[2 * e] : s1[2 * e - 4], sh = e < 2 ? s0[2 * e + 1] : s1[2 * e - 3];
        oa[e] = pk2(x1l * cl - x2l * sl, x1h * ch - x2h * sh);
        ob[e] = pk2(x1l * sl + x2l * cl, x1h * sh + x2h * ch);
    }
    a = oa; b = ob;
}

__device__ __forceinline__ void retu_phase(MLAS unsigned char* lds, const bf16_t* __restrict__ QKV, const float* __restrict__ ret_decay, const float* __restrict__ ROPE, bf16_t* __restrict__ UF, bf16_t* __restrict__ UB, int G, int bx) {
    constexpr int RS = 272, OFF_KT = 0, OFF_VF = 128 * RS, OFF_VB = 2 * 128 * RS;
    const int tid = threadIdx.x, lane = tid & 63, w = __builtin_amdgcn_readfirstlane(tid >> 6), fr_ = lane & 15, fq_ = lane >> 4;
    const int tok_ = tid & 127, dq = tid >> 7;
    const float* ccp = ROPE + (tok_ & 63) * 32 + 8 * dq;
    const f32x4 cc0 = *(const f32x4*)(ccp), cc1 = *(const f32x4*)(ccp + 4), sc0 = *(const f32x4*)(ccp + 2048), sc1 = *(const f32x4*)(ccp + 2052);
#pragma nounroll
    for (int unit = bx; unit < 64 * 18; unit += G) {
        const int bh = unit / 18, c = unit % 18, b = bh >> 2, h = bh & 3;
        const bool isctx = c < 2;
        const int rowbase = isctx ? ML + b * CTX + 128 * c : b * SEQ + 128 * (c - 2);
        const float lgf2 = ROPE[4096 + (h * 2) * 16], lgb2 = ROPE[4096 + (h * 2 + 1) * 16];
        int fr = fr_, fq = fq_, tok = tok_; asm volatile("" : "+v"(fr), "+v"(fq), "+v"(tok));
        const float ksf = __builtin_amdgcn_exp2f(lgf2 * (float)(127 - tok)), ksb = __builtin_amdgcn_exp2f(lgb2 * (float)tok);
        const bf16_t* rowp = QKV + (size_t)(rowbase + tok) * INW;
        u32x4 pk4[4], pv4[4];
#pragma unroll
        for (int p = 0; p < 4; ++p) { pk4[p] = *(const u32x4*)(rowp + C_RK + h * 128 + 8 * (dq + 4 * p)); pv4[p] = *(const u32x4*)(rowp + C_RV + h * 128 + 8 * (dq + 4 * p)); }
        if (!isctx) {
            const float* crp = ROPE + (((rowbase - b * SEQ) + tok) >> 6) * 32 + 8 * dq;
            const f32x4 cr0 = *(const f32x4*)(crp), cr1 = *(const f32x4*)(crp + 4), sr0 = *(const f32x4*)(crp + 2048), sr1 = *(const f32x4*)(crp + 2052);
            rope_pair(pk4[0], pk4[1], cr0, cr1, sr0, sr1); rope_pair(pk4[2], pk4[3], cc0, cc1, sc0, sc1);
        }
        __syncthreads();
#pragma unroll
        for (int p = 0; p < 4; ++p) {
            const int dg = dq + 4 * p;
#pragma unroll
            for (int q = 0; q < 8; ++q) { const unsigned wd = pk4[p][q >> 1]; *(MLAS bf16_t*)(lds + OFF_KT + (8 * dg + q) * RS + tok * 2) = (bf16_t)((q & 1) ? (wd >> 16) : (wd & 0xffffu)); }
#pragma unroll
            for (int q = 0; q < 4; ++q) {
                const unsigned wd = pv4[p][q]; const float vl = __uint_as_float(wd << 16), vh = __uint_as_float(wd & 0xffff0000u);
                const unsigned pf = pk2(vl * ksf, vh * ksf), pb = pk2(vl * ksb, vh * ksb);
                *(MLAS bf16_t*)(lds + OFF_VF + (8 * dg + 2 * q) * RS + tok * 2) = (bf16_t)(pf & 0xffffu); *(MLAS bf16_t*)(lds + OFF_VF + (8 * dg + 2 * q + 1) * RS + tok * 2) = (bf16_t)(pf >> 16);
                *(MLAS bf16_t*)(lds + OFF_VB + (8 * dg + 2 * q) * RS + tok * 2) = (bf16_t)(pb & 0xffffu); *(MLAS bf16_t*)(lds + OFF_VB + (8 * dg + 2 * q + 1) * RS + tok * 2) = (bf16_t)(pb >> 16);
            }
        }
        __syncthreads();
        bf16x8_t bvf[4], bvb[4];
#pragma unroll
        for (int ks = 0; ks < 4; ++ks) { bvf[ks] = *(const MLAS bf16x8_t*)(lds + OFF_VF + (16 * w + fr) * RS + (32 * ks + 8 * fq) * 2); bvb[ks] = *(const MLAS bf16x8_t*)(lds + OFF_VB + (16 * w + fr) * RS + (32 * ks + 8 * fq) * 2); }
        const int sf = isctx ? c : c, sb = isctx ? 1 - c : 19 - c;
        bf16_t* uf = UF + ((size_t)(bh * 18 + sf) * 128 + 16 * w + fr) * 128 + 4 * fq;
        bf16_t* ub = UB + ((size_t)(bh * 18 + sb) * 128 + 16 * w + fr) * 128 + 4 * fq;
#pragma unroll
        for (int dt = 0; dt < 8; ++dt) {
            f32x4 af = (f32x4){0.f, 0.f, 0.f, 0.f}, ab = (f32x4){0.f, 0.f, 0.f, 0.f};
#pragma unroll
            for (int ks = 0; ks < 4; ++ks) { const bf16x8_t ak = *(const MLAS bf16x8_t*)(lds + OFF_KT + (16 * dt + fr) * RS + (32 * ks + 8 * fq) * 2); af = MFMA16(ak, bvf[ks], af); ab = MFMA16(ak, bvb[ks], ab); }
            u32x2 pf, pb; pf.x = pk2(af[0], af[1]); pf.y = pk2(af[2], af[3]); pb.x = pk2(ab[0], ab[1]); pb.y = pk2(ab[2], ab[3]);
            *(u32x2*)(uf + 16 * dt) = pf; *(u32x2*)(ub + 16 * dt) = pb;
        }
    }
    __syncthreads();
}
__device__ __forceinline__ void rets_phase(const float* __restrict__ RETC, bf16_t* __restrict__ UF, bf16_t* __restrict__ UB, int G, int bx) {
    const int nthr = G * NTHR_;
    for (int task = bx * NTHR_ + (int)threadIdx.x; task < 128 * 2048; task += nthr) {
        const int bd = task >> 11, g8 = task & 2047, bh = bd >> 1, dir = bd & 1, h = bh & 3;
        const float cdec = RETC[(h * 2 + dir) * 16 + 9];
        bf16_t* base = (dir ? UB : UF) + (size_t)bh * 18 * 16384 + g8 * 8;
        float st[8];
#pragma unroll
        for (int e = 0; e < 8; ++e) st[e] = 0.f;
#pragma unroll
        for (int bt = 0; bt < 2; ++bt) {
            u32x4 u[9];
#pragma unroll
            for (int k = 0; k < 9; ++k) u[k] = *(const u32x4*)(base + (size_t)(9 * bt + k) * 16384);
#pragma unroll
            for (int k = 0; k < 9; ++k) {
                if (9 * bt + k >= 2) { u32x4 o; o.x = pk2(st[0], st[1]); o.y = pk2(st[2], st[3]); o.z = pk2(st[4], st[5]); o.w = pk2(st[6], st[7]);
                    *(u32x4*)(base + (size_t)(9 * bt + k) * 16384) = o; }
#pragma unroll
                for (int e = 0; e < 4; ++e) { st[2 * e] = st[2 * e] * cdec + __uint_as_float(u[k][e] << 16); st[2 * e + 1] = st[2 * e + 1] * cdec + __uint_as_float(u[k][e] & 0xffff0000u); }
            }
        }
    }
}
__device__ __forceinline__ void reto_phase(MLAS unsigned char* lds, const bf16_t* __restrict__ QKV, const float* __restrict__ ret_decay, const float* __restrict__ ROPE, const float* __restrict__ gn,
                                           const bf16_t* __restrict__ UF, const bf16_t* __restrict__ UB, bf16_t* __restrict__ MIX, int G, int bx) {
    constexpr int RS = 272, OFF_Q = 0, OFF_K = 128 * RS, OFF_VT = 2 * 128 * RS, OFF_ST = 3 * 128 * RS;
    constexpr float QS = 0.08838834764831845f;
    const int tid = threadIdx.x, lane = tid & 63, w = __builtin_amdgcn_readfirstlane(tid >> 6), fr_ = lane & 15, fq_ = lane >> 4;
    const int tok_ = tid & 127, dq = tid >> 7;
    const float* ccp = ROPE + (tok_ & 63) * 32 + 8 * dq;
    const f32x4 cc0 = *(const f32x4*)(ccp), cc1 = *(const f32x4*)(ccp + 4), sc0 = *(const f32x4*)(ccp + 2048), sc1 = *(const f32x4*)(ccp + 2052);
#pragma nounroll
    for (int unit = bx; unit < 64 * 16; unit += G) {
        const int bh = unit >> 4, n = unit & 15, b = bh >> 2, h = bh & 3;
        const int rowbase = b * SEQ + 128 * n;
        const float* rcf = ROPE + 4096 + (h * 2) * 16; const float* rcb = rcf + 16;
        const float lgf2 = rcf[0], lgb2 = rcb[0];
        int fr = fr_, fq = fq_, tok = tok_; asm volatile("" : "+v"(fr), "+v"(fq), "+v"(tok));
        const int i = 16 * w + fr;
        float dbf[4], dbb[4], dsf[8], dsb[8];
#pragma unroll
        for (int jj = 0; jj < 4; ++jj) { dbf[jj] = __builtin_amdgcn_exp2f(lgf2 * (float)(i - 4 * fq - jj)) * QS; dbb[jj] = __builtin_amdgcn_exp2f(lgb2 * (float)(4 * fq + jj - i)) * QS; }
#pragma unroll
        for (int nj = 0; nj < 8; ++nj) { dsf[nj] = rcf[1 + nj]; dsb[nj] = rcb[1 + nj]; }
        const float cscf = __builtin_amdgcn_exp2f(lgf2 * (float)(i + 1)) * QS, cscb = __builtin_amdgcn_exp2f(lgb2 * (float)(128 - i)) * QS;
        const bf16_t* rowp = QKV + (size_t)(rowbase + tok) * INW;
        u32x4 pq4[4], pk4[4], pv4[4], sfr[4], sbr[4];
#pragma unroll
        for (int p = 0; p < 4; ++p) { pq4[p] = *(const u32x4*)(rowp + C_RQ + h * 128 + 8 * (dq + 4 * p)); pk4[p] = *(const u32x4*)(rowp + C_RK + h * 128 + 8 * (dq + 4 * p)); pv4[p] = *(const u32x4*)(rowp + C_RV + h * 128 + 8 * (dq + 4 * p)); }
        const bf16_t* sfp = UF + (size_t)(bh * 18 + 2 + n) * 16384; const bf16_t* sbp = UB + (size_t)(bh * 18 + 17 - n) * 16384;
#pragma unroll
        for (int p = 0; p < 4; ++p) { const int ck = tid + 512 * p; sfr[p] = *(const u32x4*)(sfp + ck * 8); sbr[p] = *(const u32x4*)(sbp + ck * 8); }
        { const float* crp = ROPE + ((128 * n + tok) >> 6) * 32 + 8 * dq;
          const f32x4 cr0 = *(const f32x4*)(crp), cr1 = *(const f32x4*)(crp + 4), sr0 = *(const f32x4*)(crp + 2048), sr1 = *(const f32x4*)(crp + 2052);
          rope_pair(pq4[0], pq4[1], cr0, cr1, sr0, sr1); rope_pair(pq4[2], pq4[3], cc0, cc1, sc0, sc1);
          rope_pair(pk4[0], pk4[1], cr0, cr1, sr0, sr1); rope_pair(pk4[2], pk4[3], cc0, cc1, sc0, sc1); }
        __syncthreads();
#pragma unroll
        for (int p = 0; p < 4; ++p) {
            const int dg = dq + 4 * p;
            *(MLAS u32x4*)(lds + OFF_Q + tok * RS + dg * 16) = pq4[p];
            *(MLAS u32x4*)(lds + OFF_K + tok * RS + dg * 16) = pk4[p];
#pragma unroll
            for (int q = 0; q < 8; ++q) { const unsigned wd = pv4[p][q >> 1]; *(MLAS bf16_t*)(lds + OFF_VT + (8 * dg + q) * RS + tok * 2) = (bf16_t)((q & 1) ? (wd >> 16) : (wd & 0xffffu)); }
            const int ck = tid + 512 * p; *(MLAS u32x4*)(lds + OFF_ST + (ck >> 4) * RS + (ck & 15) * 16) = sfr[p];
        }
        __syncthreads();
        bf16x8_t aq[4];
#pragma unroll
        for (int ks = 0; ks < 4; ++ks) aq[ks] = *(const MLAS bf16x8_t*)(lds + OFF_Q + i * RS + (32 * ks + 8 * fq) * 2);
        f32x4 o[8];
#pragma unroll
        for (int ne = 0; ne < 8; ++ne) { o[ne] = (f32x4){0.f, 0.f, 0.f, 0.f};
#pragma unroll
            for (int ks = 0; ks < 4; ++ks) { const bf16x8_t bs = *(const MLAS bf16x8_t*)(lds + OFF_ST + (16 * ne + fr) * RS + (32 * ks + 8 * fq) * 2); o[ne] = MFMA16(bs, aq[ks], o[ne]); }
            o[ne] = o[ne] * cscf; }
        __builtin_amdgcn_sched_barrier(0);
        __syncthreads();
#pragma unroll
        for (int p = 0; p < 4; ++p) { const int ck = tid + 512 * p; *(MLAS u32x4*)(lds + OFF_ST + (ck >> 4) * RS + (ck & 15) * 16) = sbr[p]; }
        f32x4 sacc[8];
#pragma unroll
        for (int nj = 0; nj < 8; ++nj) { sacc[nj] = (f32x4){0.f, 0.f, 0.f, 0.f};
#pragma unroll
            for (int ks = 0; ks < 4; ++ks) { const bf16x8_t kf = *(const MLAS bf16x8_t*)(lds + OFF_K + (16 * nj + fr) * RS + (32 * ks + 8 * fq) * 2); sacc[nj] = MFMA16(kf, aq[ks], sacc[nj]); } }
        __builtin_amdgcn_sched_barrier(0);
        __syncthreads();
        {
#pragma unroll
            for (int ne = 0; ne < 8; ++ne) { f32x4 ob = (f32x4){0.f, 0.f, 0.f, 0.f};
#pragma unroll
                for (int ks = 0; ks < 4; ++ks) { const bf16x8_t bs = *(const MLAS bf16x8_t*)(lds + OFF_ST + (16 * ne + fr) * RS + (32 * ks + 8 * fq) * 2); ob = MFMA16(bs, aq[ks], ob); }
                o[ne] = o[ne] + ob * cscb; }
        }
        __builtin_amdgcn_sched_barrier(0);
#pragma unroll
        for (int nj = 0; nj < 8; ++nj) {
            float pv[4];
#pragma unroll
            for (int jj = 0; jj < 4; ++jj) { const int j = 16 * nj + 4 * fq + jj; pv[jj] = sacc[nj][jj] * (j <= i ? dbf[jj] * dsf[nj] : dbb[jj] * dsb[nj]); }
            u32x2 pk; pk.x = pk2(pv[0], pv[1]); pk.y = pk2(pv[2], pv[3]);
            *(MLAS u32x2*)(lds + OFF_Q + i * RS + (16 * nj + 4 * fq) * 2) = pk;
        }
        __builtin_amdgcn_sched_barrier(0);
#pragma unroll
        for (int ks = 0; ks < 4; ++ks) { const bf16x8_t bp = *(const MLAS bf16x8_t*)(lds + OFF_Q + i * RS + (32 * ks + 8 * fq) * 2);
#pragma unroll
            for (int ne = 0; ne < 8; ++ne) { const bf16x8_t av = *(const MLAS bf16x8_t*)(lds + OFF_VT + (16 * ne + fr) * RS + (32 * ks + 8 * fq) * 2); o[ne] = MFMA16(av, bp, o[ne]); } }
        __builtin_amdgcn_sched_barrier(0);
        float s1 = 0.f;
#pragma unroll
        for (int ne = 0; ne < 8; ++ne) s1 += (o[ne][0] + o[ne][1]) + (o[ne][2] + o[ne][3]);
        s1 += __shfl_xor(s1, 16); s1 += __shfl_xor(s1, 32);
        const float mean = s1 * (1.f / 128.f); float s2 = 0.f;
#pragma unroll
        for (int ne = 0; ne < 8; ++ne) { o[ne] = o[ne] - mean; s2 += (o[ne][0] * o[ne][0] + o[ne][1] * o[ne][1]) + (o[ne][2] * o[ne][2] + o[ne][3] * o[ne][3]); }
        s2 += __shfl_xor(s2, 16); s2 += __shfl_xor(s2, 32);
        const float rstd = rsqrtf(s2 * (1.f / 128.f) + EPS);
        const bf16_t* gp = QKV + (size_t)(rowbase + i) * INW + C_RG + h * 128 + 4 * fq;
        bf16_t* op = MIX + (size_t)(rowbase + i) * D + h * 128 + 4 * fq;
#pragma unroll
        for (int ne = 0; ne < 8; ++ne) {
            const u32x2 gv = *(const u32x2*)(gp + 16 * ne); const f32x4 gw4 = *(const f32x4*)(gn + h * 128 + 16 * ne + 4 * fq);
            const float g0 = __uint_as_float(gv.x << 16), g1 = __uint_as_float(gv.x & 0xffff0000u), g2 = __uint_as_float(gv.y << 16), g3 = __uint_as_float(gv.y & 0xffff0000u);
            const float y0 = o[ne][0] * rstd * gw4[0] * (g0 * __builtin_amdgcn_rcpf(1.f + __builtin_amdgcn_exp2f(-1.4426950408889634f * g0))), y1 = o[ne][1] * rstd * gw4[1] * (g1 * __builtin_amdgcn_rcpf(1.f + __builtin_amdgcn_exp2f(-1.4426950408889634f * g1)));
            const float y2 = o[ne][2] * rstd * gw4[2] * (g2 * __builtin_amdgcn_rcpf(1.f + __builtin_amdgcn_exp2f(-1.4426950408889634f * g2))), y3 = o[ne][3] * rstd * gw4[3] * (g3 * __builtin_amdgcn_rcpf(1.f + __builtin_amdgcn_exp2f(-1.4426950408889634f * g3)));
            u32x2 pk; pk.x = pk2(y0, y1); pk.y = pk2(y2, y3); *(u32x2*)(op + 16 * ne) = pk;
        }
    }
    __syncthreads();
}


struct Na2Ctx { MLAS unsigned char* lds; int fr, fq, qrow, qcol, rs, cs, cb_lo; };
template <int PASS, int T0, int NT, int NDT, int VS, int OFF_K, int OFF_V, int RING>
__device__ __forceinline__ void na2_pass(const Na2Ctx& c, const int dt0, const bf16x8_t qf0, const bf16x8_t qf1, f32x4 (&o)[NDT], float& m, float& l, const unsigned (&baddr)[12]) {
    constexpr float SC = 0.125f * 1.4426950408889634f;
    const int fr = c.fr, fq = c.fq;
    __builtin_amdgcn_sched_barrier(0);
    f32x4 sa[NT];
#pragma unroll
    for (int t = 0; t < NT; ++t) {
        const int kidx = PASS == 0 ? 16 * t : ((c.rs + (T0 + t) / 3) % RING) * 64 + 16 * (c.cb_lo + (T0 + t) % 3);
        const MLAS unsigned char* kp = c.lds + OFF_K + (kidx + fr) * 144 + 16 * fq;
        const bf16x8_t k0 = *(const MLAS bf16x8_t*)(kp), k1 = *(const MLAS bf16x8_t*)(kp + 64);
        sa[t] = MFMA16(k0, qf0, ((f32x4){0.f, 0.f, 0.f, 0.f})); sa[t] = MFMA16(k1, qf1, sa[t]);
    }
    __builtin_amdgcn_sched_barrier(0);
    float mx = m;
#pragma unroll
    for (int t = 0; t < NT; ++t) {
        if (PASS == 0) { sa[t] = sa[t] * SC; }
        else {
            const int kr = (T0 + t) / 3, cbi = (T0 + t) % 3;
#pragma unroll
            for (int jj = 0; jj < 4; ++jj) { const float bias = *(const MLAS float*)(c.lds + baddr[cbi * 4 + jj] + kr * 128); sa[t][jj] = __builtin_fmaf(sa[t][jj], SC, bias); }
        }
        mx = fmaxf(mx, fmaxf(fmaxf(sa[t][0], sa[t][1]), fmaxf(sa[t][2], sa[t][3])));
    }
    __builtin_amdgcn_sched_barrier(0);
    mx = fmaxf(mx, __shfl_xor(mx, 16)); mx = fmaxf(mx, __shfl_xor(mx, 32));
    const float alpha = __builtin_amdgcn_exp2f(m - mx);
    l *= alpha;
#pragma unroll
    for (int dd = 0; dd < NDT; ++dd) o[dd] = o[dd] * alpha;
    m = mx;
#pragma unroll
    for (int t = 0; t < NT; ++t)
#pragma unroll
        for (int jj = 0; jj < 4; ++jj) { const float pv = __builtin_amdgcn_exp2f(sa[t][jj] - m); l += pv; sa[t][jj] = pv; }
    __builtin_amdgcn_sched_barrier(0);
#pragma unroll
    for (int t2 = 0; t2 < NT / 2; ++t2) {
        const int ta = 2 * t2, tb = 2 * t2 + 1;
        const int kba = PASS == 0 ? 16 * ta : ((c.rs + (T0 + ta) / 3) % RING) * 64 + 16 * (c.cb_lo + (T0 + ta) % 3);
        const int kbb = PASS == 0 ? 16 * tb : ((c.rs + (T0 + tb) / 3) % RING) * 64 + 16 * (c.cb_lo + (T0 + tb) % 3);
        u32x4 bw; bw.x = pk2(sa[ta][0], sa[ta][1]); bw.y = pk2(sa[ta][2], sa[ta][3]); bw.z = pk2(sa[tb][0], sa[tb][1]); bw.w = pk2(sa[tb][2], sa[tb][3]);
        const bf16x8_t bP = __builtin_bit_cast(bf16x8_t, bw);
#pragma unroll
        for (int dd = 0; dd < NDT; ++dd) {
            const u32x2 vlo = *(const MLAS u32x2*)(c.lds + OFF_V + (16 * (dt0 + dd) + fr) * VS + (kba + 4 * fq) * 2);
            const u32x2 vhi = *(const MLAS u32x2*)(c.lds + OFF_V + (16 * (dt0 + dd) + fr) * VS + (kbb + 4 * fq) * 2);
            u32x4 aw; aw.x = vlo.x; aw.y = vlo.y; aw.z = vhi.x; aw.w = vhi.y;
            o[dd] = MFMA16(__builtin_bit_cast(bf16x8_t, aw), bP, o[dd]);
        }
    }
    __builtin_amdgcn_sched_barrier(0);
}
__device__ __forceinline__ void na2_phase(MLAS unsigned char* lds, const bf16_t* __restrict__ QKV, const float* __restrict__ rpb, bf16_t* __restrict__ MIX, float* __restrict__ PO, float* __restrict__ PML, int G, int bx) {
    constexpr int OFF_CK = 0, OFF_CV = 256 * 144, CVS = 256 * 2 + 16;
    constexpr int OFF_K = 0, OFF_V = 576 * 144, VS = 576 * 2 + 16, OFF_RPB = OFF_V + 64 * VS;
    const int tid = threadIdx.x, lane = tid & 63, w = __builtin_amdgcn_readfirstlane(tid >> 6), fr = lane & 15, fq = lane >> 4;
    const int stok = tid & 63, sdg = tid >> 6;
    for (int rn = bx; rn < 256; rn += G) {
        const int bh = rn >> 1, R0 = 16 * (rn & 1), b = bh >> 3, h = bh & 7;
        __syncthreads();
#pragma unroll
        for (int p = 0; p < 4; ++p) {
            const int ck = tid + 512 * p, row = ck >> 3, part = ck & 7;
            const u32x4 kv = *(const u32x4*)(QKV + (size_t)(ML + b * CTX + row) * INW + C_NK + h * 64 + 8 * part);
            *(MLAS u32x4*)(lds + OFF_CK + row * 144 + part * 16) = kv;
            const int tokc = stok + 64 * p;
            const u32x4 vv = *(const u32x4*)(QKV + (size_t)(ML + b * CTX + tokc) * INW + C_NV + h * 64 + 8 * sdg);
#pragma unroll
            for (int q = 0; q < 8; ++q) { const unsigned wd = vv[q >> 1]; *(MLAS bf16_t*)(lds + OFF_CV + (8 * sdg + q) * CVS + tokc * 2) = (bf16_t)((q & 1) ? (wd >> 16) : (wd & 0xffffu)); }
        }
        __syncthreads();
#pragma nounroll
        for (int i = 0; i < 8; ++i) {
            const int qi = w + 8 * i, qrow = R0 + (qi >> 2), qcol = 16 * (qi & 3) + fr;
            const size_t tok = (size_t)(b * SEQ + qrow * 64 + qcol);
            const bf16_t* qp = QKV + tok * INW + C_NQ + h * 64 + 8 * fq;
            const bf16x8_t qf0 = *(const bf16x8_t*)(qp), qf1 = *(const bf16x8_t*)(qp + 32);
            f32x4 o[4];
#pragma unroll
            for (int dt = 0; dt < 4; ++dt) o[dt] = (f32x4){0.f, 0.f, 0.f, 0.f};
            float m = -1e30f, l = 0.f;
            const Na2Ctx cx{lds, fr, fq, qrow, qcol, 0, 0, 0};
            const unsigned bdummy[12] = {0u, 0u, 0u, 0u, 0u, 0u, 0u, 0u, 0u, 0u, 0u, 0u};
            na2_pass<0, 0, 16, 4, CVS, OFF_CK, OFF_CV, 8>(cx, 0, qf0, qf1, o, m, l, bdummy);
            l += __shfl_xor(l, 16); l += __shfl_xor(l, 32);
            float* po = PO + (tok * 8 + h) * 64 + 4 * fq;
#pragma unroll
            for (int dt = 0; dt < 4; ++dt) *(f32x4*)(po + 16 * dt) = o[dt];
            if (fq == 0) { typedef float f32x2 __attribute__((ext_vector_type(2))); *(f32x2*)(PML + (tok * 8 + h) * 2) = (f32x2){m, l}; }
        }
        typedef float f32x2 __attribute__((ext_vector_type(2)));
        const int qt = w & 3, wr2 = w >> 2;
        const int skey = tid >> 3, spart = tid & 7;
        __syncthreads();
        if (tid < 480) { const int dr_ = tid >> 5, dc_ = tid & 31; *(MLAS float*)(lds + OFF_RPB + tid * 4) = dc_ < 31 ? rpb[h * 465 + dr_ * 31 + dc_] * 1.4426950408889634f : -1e30f; }
        const int lo0 = min(max(R0 - 4, 0), 24), hi0 = min(max(R0 - 3, 0), 24) + 7;
        for (int gr = lo0; gr <= hi0; ++gr) {
            const int slot = gr % 9;
            const u32x4 kv = *(const u32x4*)(QKV + (size_t)(b * SEQ + gr * 64 + skey) * INW + C_NK + h * 64 + 8 * spart);
            *(MLAS u32x4*)(lds + OFF_K + (slot * 64 + skey) * 144 + spart * 16) = kv;
            const u32x4 vv = *(const u32x4*)(QKV + (size_t)(b * SEQ + gr * 64 + stok) * INW + C_NV + h * 64 + 8 * sdg);
#pragma unroll
            for (int q = 0; q < 8; ++q) { const unsigned wd = vv[q >> 1]; *(MLAS bf16_t*)(lds + OFF_V + (8 * sdg + q) * VS + (slot * 64 + stok) * 2) = (bf16_t)((q & 1) ? (wd >> 16) : (wd & 0xffffu)); }
        }
        int loaded_hi = hi0;
        bf16x8_t qf0, qf1; f32x2 ml; f32x4 po[4];
        { const size_t tok = (size_t)(b * SEQ + (R0 + wr2) * 64 + 16 * qt + fr); const bf16_t* qp = QKV + tok * INW + C_NQ + h * 64 + 8 * fq;
          qf0 = *(const bf16x8_t*)(qp); qf1 = *(const bf16x8_t*)(qp + 32); ml = *(const f32x2*)(PML + (tok * 8 + h) * 2);
          const float* pp = PO + (tok * 8 + h) * 64 + 4 * fq;
#pragma unroll
          for (int dt = 0; dt < 4; ++dt) po[dt] = *(const f32x4*)(pp + 16 * dt); }
        __syncthreads();
#pragma nounroll
        for (int pi = 0; pi < 8; ++pi) {
            int frl = fr, fql = fq; asm volatile("" : "+v"(frl), "+v"(fql));
            const int r0 = R0 + 2 * pi, qrow = r0 + wr2, qcol = 16 * qt + frl;
            const int rs = min(max(qrow - 4, 0), 24);
            const int cs = min(max(qcol - 8, 0), 48), cb_lo = min(max(qt - 1, 0), 1);
            const bool hasn = pi + 1 < 8;
            const int hin = min(max(r0 - 1, 0), 24) + 7;
            const int nnew = hasn ? max(hin - loaded_hi, 0) : 0;
            u32x4 nkA, nvA, nkB, nvB; bf16x8_t nq0, nq1; f32x2 nml; f32x4 no[4];
            if (nnew >= 1) { const int gr = loaded_hi + 1;
                nkA = *(const u32x4*)(QKV + (size_t)(b * SEQ + gr * 64 + skey) * INW + C_NK + h * 64 + 8 * spart);
                nvA = *(const u32x4*)(QKV + (size_t)(b * SEQ + gr * 64 + stok) * INW + C_NV + h * 64 + 8 * sdg); }
            if (nnew >= 2) { const int gr = loaded_hi + 2;
                nkB = *(const u32x4*)(QKV + (size_t)(b * SEQ + gr * 64 + skey) * INW + C_NK + h * 64 + 8 * spart);
                nvB = *(const u32x4*)(QKV + (size_t)(b * SEQ + gr * 64 + stok) * INW + C_NV + h * 64 + 8 * sdg); }
            if (hasn) { const size_t tokn = (size_t)(b * SEQ + (qrow + 2) * 64 + qcol); const bf16_t* qp = QKV + tokn * INW + C_NQ + h * 64 + 8 * fql;
                nq0 = *(const bf16x8_t*)(qp); nq1 = *(const bf16x8_t*)(qp + 32); nml = *(const f32x2*)(PML + (tokn * 8 + h) * 2);
                const float* pp = PO + (tokn * 8 + h) * 64 + 4 * fql;
#pragma unroll
                for (int dt = 0; dt < 4; ++dt) no[dt] = *(const f32x4*)(pp + 16 * dt); }
            const size_t tok = (size_t)(b * SEQ + qrow * 64 + qcol);
            float m = ml.x, l = fql == 0 ? ml.y : 0.f;
            f32x4 o[4];
#pragma unroll
            for (int dt = 0; dt < 4; ++dt) o[dt] = po[dt];
            const Na2Ctx cx{lds, frl, fql, qrow, qcol, rs, cs, cb_lo};
            unsigned baddr[12];
#pragma unroll
            for (int e = 0; e < 12; ++e) { const int kcol = 16 * (cb_lo + (e >> 2)) + 4 * fql + (e & 3); const bool ok = (unsigned)(kcol - cs) < 16u;
                baddr[e] = (unsigned)(OFF_RPB + (rs - qrow + 7) * 128 + (ok ? kcol - qcol + 15 : 31) * 4); }
            na2_pass<1, 0, 8, 4, VS, OFF_K, OFF_V, 9>(cx, 0, qf0, qf1, o, m, l, baddr);
            na2_pass<1, 8, 8, 4, VS, OFF_K, OFF_V, 9>(cx, 0, qf0, qf1, o, m, l, baddr);
            na2_pass<1, 16, 8, 4, VS, OFF_K, OFF_V, 9>(cx, 0, qf0, qf1, o, m, l, baddr);
            l += __shfl_xor(l, 16); l += __shfl_xor(l, 32);
            const float inv = 1.f / l;
            bf16_t* op = MIX + tok * D + 512 + h * 64 + 4 * fql;
#pragma unroll
            for (int dt = 0; dt < 4; ++dt) { u32x2 pk; pk.x = pk2(o[dt][0] * inv, o[dt][1] * inv); pk.y = pk2(o[dt][2] * inv, o[dt][3] * inv); *(u32x2*)(op + 16 * dt) = pk; }
            if (hasn) {
                __syncthreads();
                if (nnew >= 1) { const int slot = (loaded_hi + 1) % 9;
                    *(MLAS u32x4*)(lds + OFF_K + (slot * 64 + skey) * 144 + spart * 16) = nkA;
#pragma unroll
                    for (int q = 0; q < 8; ++q) { const unsigned wd = nvA[q >> 1]; *(MLAS bf16_t*)(lds + OFF_V + (8 * sdg + q) * VS + (slot * 64 + stok) * 2) = (bf16_t)((q & 1) ? (wd >> 16) : (wd & 0xffffu)); } }
                if (nnew >= 2) { const int slot = (loaded_hi + 2) % 9;
                    *(MLAS u32x4*)(lds + OFF_K + (slot * 64 + skey) * 144 + spart * 16) = nkB;
#pragma unroll
                    for (int q = 0; q < 8; ++q) { const unsigned wd = nvB[q >> 1]; *(MLAS bf16_t*)(lds + OFF_V + (8 * sdg + q) * VS + (slot * 64 + stok) * 2) = (bf16_t)((q & 1) ? (wd >> 16) : (wd & 0xffffu)); } }
                loaded_hi += nnew;
                qf0 = nq0; qf1 = nq1; ml = nml;
#pragma unroll
                for (int dt = 0; dt < 4; ++dt) po[dt] = no[dt];
                __syncthreads();
            }
        }
    }
    __syncthreads();
}

#define XB_TMO      128
#define XB_XCNT(j)  (256  + 64 * (j))
#define XB_XSUB(j)  (1280 + 64 * (j))
#define XB_XGEN(j)  (2304 + 64 * (j))
#define XB_TOP      3328
#define XB_TOPGEN   3392
#define XCD_BAR_WORDS 3456
#define XB_SPIN_CAP (1u << 18)
__device__ __forceinline__ unsigned xb_ld(unsigned* p)              { return __hip_atomic_load(p, __ATOMIC_RELAXED, __HIP_MEMORY_SCOPE_AGENT); }
__device__ __forceinline__ unsigned xb_add(unsigned* p, unsigned v) { return __hip_atomic_fetch_add(p, v, __ATOMIC_RELAXED, __HIP_MEMORY_SCOPE_AGENT); }
__device__ __forceinline__ unsigned xb_xcc_id() { return (unsigned)__builtin_amdgcn_s_getreg((3 << 11) | 20) & 0xFu; }
#define XB_SPIN(cond, bar) do { unsigned _sp = 0; while (cond) { __builtin_amdgcn_s_sleep(1); \
    if ((++_sp & 255u) == 0u) { if (xb_ld(&(bar)[XB_TMO])) break; if (_sp > XB_SPIN_CAP) { atomicAdd(&(bar)[XB_TMO], 1u); break; } } } } while (0)
struct XcdBarrier { unsigned* bar; unsigned x; volatile __attribute__((address_space(3))) unsigned* st; };
__device__ __forceinline__ XcdBarrier xcd_barrier_post(unsigned* bar, volatile __attribute__((address_space(3))) unsigned* st) {
    XcdBarrier b; b.bar = bar; b.x = xb_xcc_id(); b.st = st;
    if (threadIdx.x == 0) (void)xb_add(&bar[XB_XCNT(b.x)], 1u);
    return b;
}
__device__ __forceinline__ void xcd_barrier_complete(unsigned* bar, unsigned x, unsigned& nloc, unsigned& nx) {
    const unsigned G = gridDim.x * gridDim.y * gridDim.z;
    unsigned sum, cnt, mine, sp = 0u;
    for (;;) {
        sum = 0u; cnt = 0u; mine = 0u;
#pragma unroll
        for (unsigned j = 0; j < 16; ++j) { const unsigned c = xb_ld(&bar[XB_XCNT(j)]); sum += c; cnt += (c > 0u) ? 1u : 0u; mine = (j == x) ? c : mine; }
        if (sum == G) break;
        __builtin_amdgcn_s_sleep(1);
        if ((++sp & 255u) == 0u) { if (xb_ld(&bar[XB_TMO])) break; if (sp > XB_SPIN_CAP) { atomicAdd(&bar[XB_TMO], 1u); break; } }
    }
    nloc = mine > 0u ? mine : 1u; nx = cnt > 0u ? cnt : 1u;
}
__device__ __forceinline__ void xcd_barrier(const XcdBarrier& b) {
    asm volatile("s_waitcnt vmcnt(0)" ::: "memory");
    __syncthreads();
    if (threadIdx.x == 0) {
        unsigned* bar = b.bar;
        __builtin_amdgcn_s_waitcnt(0);
        unsigned nloc = b.st[0], nx = b.st[1];
        if (nloc == 0u) { xcd_barrier_complete(bar, b.x, nloc, nx); b.st[0] = nloc; b.st[1] = nx; }
        const unsigned old = xb_add(&bar[XB_XSUB(b.x)], 1u);
        const unsigned gen = old / nloc;
        if (old + 1u == (gen + 1u) * nloc) {
            __builtin_amdgcn_fence(__ATOMIC_RELEASE, "agent");
            asm volatile("s_waitcnt vmcnt(0)" ::: "memory");
            const unsigned og = xb_add(&bar[XB_TOP], 1u);
            const unsigned tg = og / nx;
            if (og + 1u == (tg + 1u) * nx) xb_add(&bar[XB_TOPGEN], 1u);
            else XB_SPIN(xb_ld(&bar[XB_TOPGEN]) == tg, bar);
            __builtin_amdgcn_fence(__ATOMIC_ACQUIRE, "agent");
            xb_add(&bar[XB_XGEN(b.x)], 1u);
            asm volatile("s_waitcnt vmcnt(0)" ::: "memory");
        } else {
            XB_SPIN(xb_ld(&bar[XB_XGEN(b.x)]) == gen, bar);
            __builtin_amdgcn_fence(__ATOMIC_ACQUIRE, "agent");
            asm volatile("s_waitcnt vmcnt(0)" ::: "memory");
        }
    }
    __syncthreads();
}

#define LAS __attribute__((address_space(3)))
constexpr int NWAVES = 8, NTHR = 512;
constexpr int LDS_BYTES = 163840;
constexpr size_t WS_WIN = 2 * MiB, WS_WOUT = 9 * MiB, WS_W1 = 11 * MiB, WS_W2 = 19 * MiB;

struct Args { const float* in[17]; float* out; unsigned char* ws; int ph_lo, ph_hi; };


__device__ __forceinline__ void transpose_item(const float* __restrict__ W, int K, int N, bf16_t* __restrict__ WT, LAS float* scr, int item, int lane) {
    const int nblk = N / 32, kb = item / nblk, nb = item % nblk, k0 = 64 * kb, n0 = 32 * nb;
#pragma unroll 8
    for (int i = 0; i < 32; ++i) { const int kk = 2 * i + (lane >> 5); scr[kk * 33 + (lane & 31)] = W[(size_t)(k0 + kk) * N + n0 + (lane & 31)]; }
    asm volatile("s_waitcnt lgkmcnt(0)" ::: "memory");
    const int c = lane & 7;
#pragma unroll
    for (int j = 0; j < 4; ++j) { const int n = (lane >> 3) + 8 * j; const LAS float* s = scr + (8 * c) * 33 + n;
        u32x4 o; o.x = pk2(s[0 * 33], s[1 * 33]); o.y = pk2(s[2 * 33], s[3 * 33]); o.z = pk2(s[4 * 33], s[5 * 33]); o.w = pk2(s[6 * 33], s[7 * 33]);
        *(u32x4*)(WT + (size_t)(n0 + n) * K + k0 + 8 * c) = o; }
    asm volatile("s_waitcnt lgkmcnt(0)" ::: "memory");
}

__global__ void __launch_bounds__(NTHR, 2) mega(Args args) {
    extern __shared__ __attribute__((aligned(16))) unsigned char lds_raw[];
    LAS unsigned char* lds = (LAS unsigned char*)lds_raw;
    const int tid = threadIdx.x, lane = tid & 63, wave = __builtin_amdgcn_readfirstlane(tid >> 6);
    const int G = gridDim.x, bx = blockIdx.x;
    const int gw = bx * NWAVES + wave, NGW = G * NWAVES;
    const int vcu = (G % 8 == 0) ? (bx % 8) * (G / 8) + bx / 8 : bx;
    const int lo = args.ph_lo, hi = args.ph_hi;
    unsigned char* ws = args.ws;
    const float* x = args.in[0]; const float* c = args.in[1]; const float* ctx = args.in[2]; const float* c_ctx = args.in[3];
    const float* w_ada = args.in[4]; const float* b_ada = args.in[5];
    const float* g_pre_mix = args.in[6]; const float* g_post_mix = args.in[7]; const float* g_pre_mlp = args.in[8]; const float* g_post_mlp = args.in[9];
    const float* w_in = args.in[10]; const float* w_out = args.in[14]; const float* w_mlp1 = args.in[15]; const float* w_mlp2 = args.in[16];
    float* out = args.out;
    float* MOD = (float*)(ws + WS_MOD); bf16_t* XN = (bf16_t*)(ws + WS_XN); bf16_t* QKV = (bf16_t*)(ws + WS_QKV); bf16_t* HID = (bf16_t*)(ws + WS_HID);
    bf16_t* MIX = (bf16_t*)(ws + WS_MIX); float* Y = (float*)(ws + WS_Y); bf16_t* H2 = XN;
    bf16_t* WinT = (bf16_t*)(ws + WS_WIN); bf16_t* WoutT = (bf16_t*)(ws + WS_WOUT); bf16_t* W1T = (bf16_t*)(ws + WS_W1); bf16_t* W2T = (bf16_t*)(ws + WS_W2);
#define IN(k) (lo <= (k) && (k) < hi)
    volatile LAS unsigned* stw = (volatile LAS unsigned*)(lds + LDS_BYTES - 64);
    if (tid < 2) stw[tid] = 0u;
    __syncthreads();
    XcdBarrier xbar = xcd_barrier_post((unsigned*)ws, stw);
    if (lo < 0) cg::this_grid().sync();
#define GSYNC() xcd_barrier(xbar)
#define SEAM(k) do { if (IN(k) && IN((k) + 1)) GSYNC(); } while (0)

    if (IN(0)) {
        if (bx < 96) {
            LAS float* sl = (LAS float*)lds;
            LAS float* red = (LAS float*)(lds + 72 * 1024);
            for (int e = tid; e < 17 * 1024; e += NTHR) { const float v = e < 16 * 1024 ? c[e] : c_ctx[e - 16 * 1024]; sl[e] = v / (1.f + expf(-v)); }
            __syncthreads();
            const int col = bx * 64 + lane;
            float acc[17];
#pragma unroll
            for (int r = 0; r < 17; ++r) acc[r] = 0.f;
            for (int k0 = wave * 128; k0 < wave * 128 + 128; k0 += 16) {
                float wv[16];
#pragma unroll
                for (int u = 0; u < 16; ++u) wv[u] = w_ada[(size_t)(k0 + u) * 6144 + col];
#pragma unroll
                for (int u = 0; u < 16; ++u)
#pragma unroll
                    for (int r = 0; r < 17; ++r) acc[r] += sl[r * 1024 + k0 + u] * wv[u];
            }
#pragma unroll
            for (int r = 0; r < 17; ++r) red[(wave * 17 + r) * 64 + lane] = acc[r];
            __syncthreads();
            for (int e = tid; e < 17 * 64; e += NTHR) { const int r = e >> 6, cc = e & 63; float s = b_ada[bx * 64 + cc];
#pragma unroll
                for (int w = 0; w < 8; ++w) s += red[(w * 17 + r) * 64 + cc];
                MOD[r * 6144 + bx * 64 + cc] = s; }
            __syncthreads();
        }
        if (bx == G - 1) { float* ROPE = (float*)(ws + WS_ROPE);
            for (int e = tid; e < 64 * 32; e += NTHR) { const float inv = exp2f(-(float)(e & 31) * (13.287712379549449f / 32.f)); const float ang = (float)(e >> 5) * inv; ROPE[e] = cosf(ang); ROPE[2048 + e] = sinf(ang); }
            if (tid < 8) { const int h_ = tid >> 1, dir_ = tid & 1; const float lg2_ = -log1pf(expf(-args.in[11][dir_ * 4 + h_])) * 1.4426950408889634f; float* rc = ROPE + 4096 + tid * 16;
                rc[0] = lg2_; for (int nj = 0; nj < 8; ++nj) rc[1 + nj] = exp2f((dir_ ? 16.f : -16.f) * lg2_ * (float)nj); rc[9] = exp2f(128.f * lg2_); } }
        LAS float* scr = (LAS float*)(lds + wave * 16384);
        constexpr int I_IN = (D / 64) * (INW / 32), I_O = (D / 64) * (D / 32), I_1 = (D / 64) * (FF / 32), I_2 = (FF / 64) * (D / 32);
        for (int it = gw; it < I_IN + I_O + I_1 + I_2; it += NGW) {
            int r = it;
            if (r < I_IN) { transpose_item(w_in, D, INW, WinT, scr, r, lane); continue; } r -= I_IN;
            if (r < I_O) { transpose_item(w_out, D, D, WoutT, scr, r, lane); continue; } r -= I_O;
            if (r < I_1) { transpose_item(w_mlp1, D, FF, W1T, scr, r, lane); continue; } r -= I_1;
            transpose_item(w_mlp2, FF, D, W2T, scr, r, lane);
        }
    }
    SEAM(0);
    if (IN(1)) {
        const int rpw = (MT + NGW - 1) / NGW, r0 = gw * rpw, r1 = min(MT, r0 + rpw);
        int curb = -1; f32x4 Bc[4], Cc[4], v[4], nv[4];
        if (r0 < r1) { const float* src = r0 < ML ? x + (size_t)r0 * D : ctx + (size_t)(r0 - ML) * D;
#pragma unroll
            for (int j = 0; j < 4; ++j) v[j] = *(const f32x4*)(src + 256 * j + 4 * lane); }
        for (int row = r0; row < r1; ++row) {
            if (row + 1 < r1) { const int rn = row + 1; const float* src = rn < ML ? x + (size_t)rn * D : ctx + (size_t)(rn - ML) * D;
#pragma unroll
                for (int j = 0; j < 4; ++j) nv[j] = *(const f32x4*)(src + 256 * j + 4 * lane); }
            const int b = row < ML ? row / SEQ : 16;
            if (b != curb) { curb = b; const float* sh = MOD + b * 6144; const float* sc = sh + 1024;
#pragma unroll
                for (int j = 0; j < 4; ++j) { const int col = 256 * j + 4 * lane; Bc[j] = *(const f32x4*)(g_pre_mix + col) * (*(const f32x4*)(sc + col) + 1.f); Cc[j] = *(const f32x4*)(sh + col); } }
            float ss = 0.f;
#pragma unroll
            for (int j = 0; j < 4; ++j) ss += v[j].x * v[j].x + v[j].y * v[j].y + v[j].z * v[j].z + v[j].w * v[j].w;
            const float r = rsqrtf(wave_sum(ss) * (1.f / D) + EPS);
#pragma unroll
            for (int j = 0; j < 4; ++j) {
                const f32x4 o = v[j] * r * Bc[j] + Cc[j];
                u32x2 pk; pk.x = pk2(o.x, o.y); pk.y = pk2(o.z, o.w);
                *(u32x2*)(XN + (size_t)row * D + 256 * j + 4 * lane) = pk;
            }
#pragma unroll
            for (int j = 0; j < 4; ++j) v[j] = nv[j];
        }
    }
    SEAM(1);
    if (IN(2)) {
        pg8::Gemm g{XN, WinT, MT, INW, D}; pg8::StaticOrder S; S.init(MT, INW, G, bx);
        pg8::EpiBf16<0> E{QKV, INW};
        pg8::gemm_phase(lds, g, S, E);
    }
    SEAM(2);
    if (IN(4)) {
        retu_phase(lds, QKV, args.in[11], (const float*)(ws + WS_ROPE), (bf16_t*)(ws + WS_UF), (bf16_t*)(ws + WS_UB), G, vcu);
        na2_phase(lds, QKV, args.in[13], MIX, out, out + (size_t)ML * 8 * 64, G, vcu);
    }
    if (IN(4) && IN(5)) GSYNC();
    if (IN(4)) rets_phase((const float*)(ws + WS_ROPE) + 4096, (bf16_t*)(ws + WS_UF), (bf16_t*)(ws + WS_UB), G, bx);
    if (IN(4) && IN(5)) GSYNC();
    if (IN(4)) reto_phase(lds, QKV, args.in[11], (const float*)(ws + WS_ROPE), args.in[12], (const bf16_t*)(ws + WS_UF), (const bf16_t*)(ws + WS_UB), MIX, G, vcu);
    SEAM(4);
    if (IN(5)) {
        pg8::Gemm g{MIX, WoutT, ML, D, D}; pg8::StaticOrder S; S.init(ML, D, G, bx);
        pg8::EpiBf16<0> E{(bf16_t*)(ws + WS_RPB), D};
        pg8::gemm_phase(lds, g, S, E);
    }
    SEAM(5);
    if (IN(6)) {
        const bf16_t* T = (const bf16_t*)(ws + WS_RPB);
        {
        bf16_t* H2w = H2;
        const int rpw = (ML + NGW - 1) / NGW, r0 = gw * rpw, r1 = min(ML, r0 + rpw);
        int curb = -1; f32x4 Ac[4], Bc[4], Cc[4], xv[4], nx[4]; u32x2 tv[4], nt[4];
        if (r0 < r1) {
#pragma unroll
            for (int j = 0; j < 4; ++j) { tv[j] = *(const u32x2*)(T + (size_t)r0 * D + 256 * j + 4 * lane); xv[j] = *(const f32x4*)(x + (size_t)r0 * D + 256 * j + 4 * lane); } }
        for (int row = r0; row < r1; ++row) {
            if (row + 1 < r1) {
#pragma unroll
                for (int j = 0; j < 4; ++j) { nt[j] = *(const u32x2*)(T + (size_t)(row + 1) * D + 256 * j + 4 * lane); nx[j] = *(const f32x4*)(x + (size_t)(row + 1) * D + 256 * j + 4 * lane); } }
            const int b = row / SEQ;
            if (b != curb) { curb = b; const float* md = MOD + b * 6144;
#pragma unroll
                for (int j = 0; j < 4; ++j) { const int col = 256 * j + 4 * lane; Ac[j] = *(const f32x4*)(md + 2048 + col) * *(const f32x4*)(g_post_mix + col);
                    Bc[j] = *(const f32x4*)(g_pre_mlp + col) * (*(const f32x4*)(md + 4096 + col) + 1.f); Cc[j] = *(const f32x4*)(md + 3072 + col); } }
            f32x4 t[4]; float ss = 0.f;
#pragma unroll
            for (int j = 0; j < 4; ++j) { t[j] = (f32x4){__uint_as_float(tv[j].x << 16), __uint_as_float(tv[j].x & 0xffff0000u), __uint_as_float(tv[j].y << 16), __uint_as_float(tv[j].y & 0xffff0000u)};
                ss += t[j].x * t[j].x + t[j].y * t[j].y + t[j].z * t[j].z + t[j].w * t[j].w; }
            const float r = rsqrtf(wave_sum(ss) * (1.f / D) + EPS);
            float ss2 = 0.f;
#pragma unroll
            for (int j = 0; j < 4; ++j) { t[j] = xv[j] + Ac[j] * (t[j] * r); ss2 += t[j].x * t[j].x + t[j].y * t[j].y + t[j].z * t[j].z + t[j].w * t[j].w;
                }
            const float r2 = rsqrtf(wave_sum(ss2) * (1.f / D) + EPS);
#pragma unroll
            for (int j = 0; j < 4; ++j) { const f32x4 o = t[j] * r2 * Bc[j] + Cc[j]; u32x2 pk; pk.x = pk2(o.x, o.y); pk.y = pk2(o.z, o.w);
                *(u32x2*)(H2w + (size_t)row * D + 256 * j + 4 * lane) = pk; }
#pragma unroll
            for (int j = 0; j < 4; ++j) { tv[j] = nt[j]; xv[j] = nx[j]; }
        }
        }
    }
    SEAM(6);
    if (IN(7)) {
        pg8::Gemm g{H2, W1T, ML, FF, D}; pg8::StaticOrder S; S.init(ML, FF, G, bx);
        pg8::EpiBf16<1> E{HID, FF};
        pg8::gemm_phase(lds, g, S, E);
    }
    SEAM(7);
    if (IN(8)) {
        pg8::Gemm g{HID, W2T, ML, D, FF}; pg8::StaticOrder S; S.init(ML, D, G, bx);
        pg8::EpiBf16<0> E{(bf16_t*)Y, D};
        pg8::gemm_phase(lds, g, S, E);
    }
    SEAM(8);
    if (IN(9)) {
        const bf16_t* Yb = (const bf16_t*)Y; const bf16_t* T = (const bf16_t*)(ws + WS_RPB);
        {
        float* outw = out;
        const int rpw = (ML + NGW - 1) / NGW, r0 = gw * rpw, r1 = min(ML, r0 + rpw);
        int curb = -1; f32x4 A1[4], A2[4], xv[4], nx[4]; u32x2 tv[4], nt[4], yv[4], ny[4];
        if (r0 < r1) {
#pragma unroll
            for (int j = 0; j < 4; ++j) { const size_t o_ = (size_t)r0 * D + 256 * j + 4 * lane; tv[j] = *(const u32x2*)(T + o_); yv[j] = *(const u32x2*)(Yb + o_); xv[j] = *(const f32x4*)(x + o_); } }
        for (int row = r0; row < r1; ++row) {
            if (row + 1 < r1) {
#pragma unroll
                for (int j = 0; j < 4; ++j) { const size_t o_ = (size_t)(row + 1) * D + 256 * j + 4 * lane; nt[j] = *(const u32x2*)(T + o_); ny[j] = *(const u32x2*)(Yb + o_); nx[j] = *(const f32x4*)(x + o_); } }
            const int b = row / SEQ;
            if (b != curb) { curb = b; const float* md = MOD + b * 6144;
#pragma unroll
                for (int j = 0; j < 4; ++j) { const int col = 256 * j + 4 * lane; A1[j] = *(const f32x4*)(md + 2048 + col) * *(const f32x4*)(g_post_mix + col); A2[j] = *(const f32x4*)(md + 5120 + col) * *(const f32x4*)(g_post_mlp + col); } }
            f32x4 t[4], y[4]; float ss = 0.f, sy = 0.f;
#pragma unroll
            for (int j = 0; j < 4; ++j) { t[j] = (f32x4){__uint_as_float(tv[j].x << 16), __uint_as_float(tv[j].x & 0xffff0000u), __uint_as_float(tv[j].y << 16), __uint_as_float(tv[j].y & 0xffff0000u)};
                y[j] = (f32x4){__uint_as_float(yv[j].x << 16), __uint_as_float(yv[j].x & 0xffff0000u), __uint_as_float(yv[j].y << 16), __uint_as_float(yv[j].y & 0xffff0000u)};
                ss += t[j].x * t[j].x + t[j].y * t[j].y + t[j].z * t[j].z + t[j].w * t[j].w; sy += y[j].x * y[j].x + y[j].y * y[j].y + y[j].z * y[j].z + y[j].w * y[j].w; }
            const float r = rsqrtf(wave_sum(ss) * (1.f / D) + EPS), ry = rsqrtf(wave_sum(sy) * (1.f / D) + EPS);
#pragma unroll
            for (int j = 0; j < 4; ++j) { const f32x4 x1 = xv[j] + A1[j] * (t[j] * r); *(f32x4*)(outw + (size_t)row * D + 256 * j + 4 * lane) = x1 + A2[j] * (y[j] * ry); }
#pragma unroll
            for (int j = 0; j < 4; ++j) { tv[j] = nt[j]; yv[j] = ny[j]; xv[j] = nx[j]; }
        }
        }
    }
#undef IN
#undef SEAM
}

static void launch_mega(Args a, int lo, int hi, int grid, hipStream_t stream) {
    a.ph_lo = lo; a.ph_hi = hi;
    if (hi - lo > 1) {
        void* kargs[] = {&a};
        hipError_t e = hipLaunchCooperativeKernel((const void*)mega, dim3(grid), dim3(NTHR), kargs, LDS_BYTES, stream);
        if (e != hipSuccess) fprintf(stderr, "cooperative launch failed: %s (grid %d)\n", hipGetErrorString(e), grid);
    } else {
        hipLaunchKernelGGL(mega, dim3(grid), dim3(NTHR), LDS_BYTES, stream, a);
    }
}

extern "C" void kernel_launch(void* const* d_in, const int* in_sizes, int n_in, void* d_out, int out_size, void* d_ws, size_t ws_size, hipStream_t stream) {
    static int grid = 0;
    if (grid == 0) {
        if (ws_size < WS_END || n_in != 17) { fprintf(stderr, "kernel_launch: bad ws/n_in: %zu %d\n", ws_size, n_in); grid = -1; return; }
        int dev = 0, cus = 0, per_cu = 0;
        (void)hipGetDevice(&dev); (void)hipDeviceGetAttribute(&cus, hipDeviceAttributeMultiprocessorCount, dev);
        if (hipFuncSetAttribute((const void*)mega, hipFuncAttributeMaxDynamicSharedMemorySize, LDS_BYTES) != hipSuccess) { fprintf(stderr, "hipFuncSetAttribute failed\n"); grid = -1; return; }
        if (hipOccupancyMaxActiveBlocksPerMultiprocessor(&per_cu, (const void*)mega, NTHR, LDS_BYTES) != hipSuccess || per_cu < 1) { fprintf(stderr, "occupancy query: %d\n", per_cu); per_cu = 1; }
        (void)hipGetLastError();
        grid = (cus > 0 ? cus : 256) * 1;
    }
    if (grid < 0) return;
    Args a{};
    for (int i = 0; i < 17; ++i) a.in[i] = (const float*)d_in[i];
    a.out = (float*)d_out; a.ws = (unsigned char*)d_ws;
    (void)hipMemsetAsync(d_ws, 0, 16384, stream);
    launch_mega(a, 0, 10, grid, stream);
}
```
